# Optimizing an MI355X kernel written in HIP

```python
import jax, jax.numpy as jnp
from jax import lax
import numpy as np

D_MODEL = 1024
BATCH = 8
SEQ = 2048
DEPTH = 4
DEC_BATCH = 128
DEC_SEQ = 4
PAST_LEN = 16384
PAGE_SIZE = 128

EPS = 1e-6
N_A = (DEPTH + 1) // 2
N_B = DEPTH // 2
CHUNK = 128
D_V = 2 * D_MODEL
H_A = 8
HD_A = D_V // H_A
POOL_WINDOWS = (2, 4, 8, 16)
N_POOL_GROUPS = len(POOL_WINDOWS)
GD_B = D_MODEL // N_POOL_GROUPS
POOL_BUF = max(POOL_WINDOWS) - 1
D_FF = 2816
CONV_W = 3

kernel_name = "hybrid_gmlp_pool_convffn_step"


def rmsnorm(x, g):
    xf = x.astype(jnp.float32)
    y = xf * lax.rsqrt(jnp.mean(xf * xf, axis=-1, keepdims=True) + EPS)
    return (y * g.astype(jnp.float32)).astype(x.dtype)


def gmlp_mixer(h, w_in, g_v, w_s, b_s, w_out):
    B, T, _ = h.shape
    z = jax.nn.gelu(jnp.einsum('btd,de->bte', h, w_in))
    u, v = jnp.split(z, 2, axis=-1)
    v = rmsnorm(v, g_v)
    n_chunks = -(-T // CHUNK)
    pad = n_chunks * CHUNK - T
    vp = jnp.pad(v, ((0, 0), (0, pad), (0, 0))).reshape(B, n_chunks, CHUNK, H_A, HD_A)
    mask = jnp.tril(jnp.ones((CHUNK, CHUNK), dtype=w_s.dtype))
    ws = w_s * mask[None]
    s = jnp.einsum('hij,bcjhe->bcihe', ws, vp) + jnp.transpose(b_s)[None, None, :, :, None]
    s = s.reshape(B, n_chunks * CHUNK, D_V)[:, :T]
    y = jnp.einsum('bte,ed->btd', u * s, w_out)
    return y, v


def pool_mixer(h, buf, start_pos, w_pool, scale):
    B, T, D = h.shape
    L = POOL_BUF
    hc = jnp.concatenate([buf.astype(h.dtype), h], axis=1).astype(jnp.float32)
    c = jnp.pad(jnp.cumsum(hc, axis=1), ((0, 0), (1, 0), (0, 0)))
    pos = start_pos + jnp.arange(T)
    end = c[:, L + 1:]
    means = []
    for g, w in enumerate(POOL_WINDOWS):
        sl = slice(g * GD_B, (g + 1) * GD_B)
        begin = c[:, L + 1 - w:L + 1 - w + T, sl]
        cnt = jnp.minimum(w, pos + 1).astype(jnp.float32)[None, :, None]
        means.append((end[..., sl] - begin) / cnt)
    mean = jnp.concatenate(means, axis=-1)
    p = (mean - hc[:, L:]).astype(h.dtype).reshape(B, T, N_POOL_GROUPS, GD_B)
    y = jnp.einsum('btgc,gce->btge', p, w_pool).reshape(B, T, D)
    return y * scale, hc[:, -L:].astype(h.dtype)


def conv_ffn(h, buf, w_gate, w_val, conv_w, conv_b, w_down):
    T = h.shape[1]
    a = jnp.einsum('btd,df->btf', h, w_gate)
    val = jnp.einsum('btd,df->btf', h, w_val)
    ac = jnp.concatenate([buf.astype(a.dtype), a], axis=1)
    conv = conv_b + conv_w[0] * ac[:, 0:T]
    for k in range(1, CONV_W):
        conv = conv + conv_w[k] * ac[:, k:k + T]
    y = jnp.einsum('btf,fd->btd', jax.nn.silu(conv) * val, w_down)
    return y, ac[:, -(CONV_W - 1):]


def trunk(x, start_pos, pool_bufs, conv_bufs, norm_mix, norm_ffn, norm_final,
          w_in_a, g_v_a, w_s_a, b_s_a, w_out_a, w_pool_b, scale_b,
          w_gate, w_val, conv_w, conv_b, w_down):
    v_rows, pool_new, conv_new = [], [], []
    for i in range(DEPTH):
        h = rmsnorm(x, norm_mix[i])
        j = i // 2
        if i % 2 == 0:
            y, v = gmlp_mixer(h, w_in_a[j], g_v_a[j], w_s_a[j], b_s_a[j], w_out_a[j])
            v_rows.append(v)
        else:
            y, pb = pool_mixer(h, pool_bufs[j], start_pos, w_pool_b[j], scale_b[j])
            pool_new.append(pb)
        x = x + y
        h = rmsnorm(x, norm_ffn[i])
        y, cb = conv_ffn(h, conv_bufs[i], w_gate[i], w_val[i], conv_w[i], conv_b[i], w_down[i])
        conv_new.append(cb)
        x = x + y
    return rmsnorm(x, norm_final), jnp.stack(v_rows), jnp.stack(pool_new), jnp.stack(conv_new)


def setup_inputs(seed: int = 0) -> dict:
    key = jax.random.key(seed)
    ks = jax.random.split(key, 20)
    f32 = jnp.float32
    nrm = lambda k, shape, s: jax.random.normal(k, shape, f32) * s
    return {
        "x_prompt": nrm(ks[0], (BATCH, SEQ, D_MODEL), 1.0),
        "x_sample": nrm(ks[1], (DEC_BATCH, DEC_SEQ, D_MODEL), 1.0),
        "state_pool": nrm(ks[2], (N_B, DEC_BATCH, POOL_BUF, D_MODEL), 1.0),
        "state_ffn_conv": nrm(ks[3], (DEPTH, DEC_BATCH, CONV_W - 1, D_FF), 0.5),
        "norm_mix": 1.0 + nrm(ks[4], (DEPTH, D_MODEL), 0.05),
        "norm_ffn": 1.0 + nrm(ks[5], (DEPTH, D_MODEL), 0.05),
        "norm_final": 1.0 + nrm(ks[6], (D_MODEL,), 0.05),
        "w_in_a": nrm(ks[7], (N_A, D_MODEL, 2 * D_V), D_MODEL ** -0.5),
        "g_v_a": 1.0 + nrm(ks[8], (N_A, D_V), 0.05),
        "w_s_a": nrm(ks[9], (N_A, H_A, CHUNK, CHUNK), CHUNK ** -0.5),
        "b_s_a": 1.0 + nrm(ks[10], (N_A, H_A, CHUNK), 0.05),
        "w_out_a": nrm(ks[11], (N_A, D_V, D_MODEL), D_V ** -0.5),
        "w_pool_b": nrm(ks[12], (N_B, N_POOL_GROUPS, GD_B, GD_B), GD_B ** -0.5),
        "scale_b": 1.0 + nrm(ks[13], (N_B, D_MODEL), 0.1),
        "w_gate": nrm(ks[14], (DEPTH, D_MODEL, D_FF), D_MODEL ** -0.5),
        "w_val": nrm(ks[15], (DEPTH, D_MODEL, D_FF), D_MODEL ** -0.5),
        "conv_w": nrm(ks[16], (DEPTH, CONV_W, D_FF), CONV_W ** -0.5),
        "conv_b": nrm(ks[17], (DEPTH, D_FF), 0.01),
        "w_down": nrm(ks[18], (DEPTH, D_FF, D_MODEL), D_FF ** -0.5),
    }


def reference(x_prompt, x_sample, state_pool, state_ffn_conv, norm_mix, norm_ffn, norm_final,
              w_in_a, g_v_a, w_s_a, b_s_a, w_out_a, w_pool_b, scale_b,
              w_gate, w_val, conv_w, conv_b, w_down):
    weights = (norm_mix, norm_ffn, norm_final, w_in_a, g_v_a, w_s_a, b_s_a, w_out_a,
               w_pool_b, scale_b, w_gate, w_val, conv_w, conv_b, w_down)
    pool0 = jnp.zeros((N_B, BATCH, POOL_BUF, D_MODEL), x_prompt.dtype)
    conv0 = jnp.zeros((DEPTH, BATCH, CONV_W - 1, D_FF), x_prompt.dtype)
    y_prompt, _, pool_prompt, ffn_conv_prompt = trunk(x_prompt, 0, pool0, conv0, *weights)
    y_sample, gmlp_v_sample, pool_sample, ffn_conv_sample = trunk(
        x_sample, PAST_LEN, state_pool, state_ffn_conv, *weights)
    return (y_prompt, y_sample, gmlp_v_sample, pool_prompt, pool_sample, ffn_conv_prompt, ffn_conv_sample)
```

```cpp
#include <hip/hip_runtime.h>
#include <cstdio>
#include <cstdint>
#define N_LAUNCH_SPLIT 0
namespace pg8 {
#define PG8_LAS __attribute__((address_space(3)))
typedef unsigned short bf16_t;
typedef short bf16x8 __attribute__((ext_vector_type(8)));
typedef float f32x4 __attribute__((ext_vector_type(4)));
typedef unsigned u32x4 __attribute__((ext_vector_type(4)));
constexpr int BM = 256, BK = 64, HALF = 128, HTB = HALF * BK * 2  , STAGE_BYTES = 8 * HTB, NXCD = 8, WGM = 8;

__host__ __device__ __forceinline__ int lds_byte(int r, int c) { const int st = (r >> 4) * 2 + (c >> 5), rr = r & 15, cc = c & 31, ob = rr * 64 + cc * 2; return st * 1024 + (ob ^ (((ob >> 9) & 1) << 5)); }
__host__ __device__ __forceinline__ void stage_rc(int b, int& R, int& C) { const int st = b / 1024, sb = b % 1024, swz = sb ^ (((sb >> 9) & 1) << 5); R = (st >> 1) * 16 + swz / 64; C = (st & 1) * 32 + (swz % 64) / 2; }
__host__ __device__ __forceinline__ int perm32(int rho) { const int n = rho >> 4, i = rho & 15; return 8 * (i >> 2) + 4 * n + (i & 3); }

struct Unit { int pm, pn; };
struct Gemm { const bf16_t* A; const bf16_t* Bt; int M, N, K; };

struct StaticOrder {
    int nM, nN, nwg, G, c;
    __host__ __device__ void init(int M, int N, int G_, int c_) { nM = M / BM; nN = N / BM; nwg = nM * nN; G = G_; c = c_; }
    __host__ __device__ bool next(int i, Unit& u) const {
        const long L = (long)i * G + c; if (L >= nwg) return false;
        int wgid = (int)L; { const int q = nwg / NXCD, r = nwg % NXCD, xcd = wgid % NXCD, off = wgid / NXCD; wgid = (xcd < r ? xcd * (q + 1) : r * (q + 1) + (xcd - r) * q) + off; }
        const int nig = WGM * nN, gid = wgid / nig, fm = gid * WGM, gsz = (nM - fm) < WGM ? (nM - fm) : WGM;
        u.pm = fm + ((wgid % nig) % gsz); u.pn = (wgid % nig) / gsz; return true;
    }
    __device__ __forceinline__ void a_ready(const Unit&) const {}
    __device__ __forceinline__ void done(const Unit&) const {}
};

template <class Epi, class Sched, bool ALIGN_EPI = false, bool SP2 = false>
__device__ __forceinline__ void gemm_phase(PG8_LAS unsigned char* lds, const Gemm g, const Sched& S, const Epi& E) {
    int tid_ = threadIdx.x; asm volatile("" : "+v"(tid_)); const int tid = tid_, wid = __builtin_amdgcn_readfirstlane(tid >> 6), lane = tid & 63, wr = wid >> 2, wc = wid & 3, fr = lane & 15, fq = lane >> 4;
    const int K = g.K, nt = K / BK;
    unsigned voffA[2], voffB[2];
#pragma unroll
    for (int i = 0; i < 2; ++i) { int R, C; stage_rc(tid * 16 + i * 8192, R, C); const int Rb = Epi::PERM ? ((R & ~31) + perm32(R & 31)) : R;
        voffA[i] = (unsigned)(R * K + C) * 2u; voffB[i] = (unsigned)(Rb * K + C) * 2u; }
    const size_t kstep = (size_t)(BK * 2);
    const size_t hstep = (size_t)HALF * K * 2;
    const size_t tstep = 2 * hstep;
    const unsigned ldsw = (unsigned)wid * 1024u;
    const int aoff = lds_byte(wr * 64 + fr, fq * 8), boff = lds_byte(wc * 32 + fr, fq * 8);
#define PG8_SA(b, h) (((b) * 2 + (h)) * HTB)
#define PG8_SB(b, h) ((4 + (b) * 2 + (h)) * HTB)
#define PG8_STAGE(bufoff, gbase, voff) do { _Pragma("unroll") for (int _i = 0; _i < 2; ++_i) \
        __builtin_amdgcn_global_load_lds((const unsigned*)((const char*)(gbase) + (voff)[_i]), (PG8_LAS unsigned*)(lds + (bufoff) + ldsw + _i * 8192), 16, 0, 0); } while (0)
#define PG8_LDA(dst, b, h) do { _Pragma("unroll") for (int m = 0; m < 4; ++m) _Pragma("unroll") for (int k = 0; k < 2; ++k) dst[m][k] = *(const PG8_LAS bf16x8*)(lds + PG8_SA(b, h) + aoff + m * 2048 + k * 1024); } while (0)
#define PG8_LDB(dst, b, h) do { _Pragma("unroll") for (int n = 0; n < 2; ++n) _Pragma("unroll") for (int k = 0; k < 2; ++k) dst[n][k] = *(const PG8_LAS bf16x8*)(lds + PG8_SB(b, h) + boff + n * 2048 + k * 1024); } while (0)
#define PG8_MMA(ai, bj, At, Bt) do { __builtin_amdgcn_s_setprio(1); _Pragma("unroll") for (int m = 0; m < 4; ++m) _Pragma("unroll") for (int n = 0; n < 2; ++n) _Pragma("unroll") for (int k = 0; k < 2; ++k) \
        acc[ai][bj][m][n] = __builtin_amdgcn_mfma_f32_16x16x32_bf16(Bt[n][k], At[m][k], acc[ai][bj][m][n], 0, 0, 0); __builtin_amdgcn_s_setprio(0); } while (0)
#define PG8_WAIT_V(n) asm volatile("s_waitcnt vmcnt(" #n ")" ::: "memory")
#define PG8_WAIT_L(n) asm volatile("s_waitcnt lgkmcnt(" #n ")" ::: "memory")
#define PG8_BAR __builtin_amdgcn_s_barrier()
#define PG8_SCHED __builtin_amdgcn_sched_barrier(0)
    Unit cur, nxt; int ui = 0;
    if (!S.next(0, cur)) return;
    f32x4 acc[2][2][4][2];
#pragma unroll
    for (int a = 0; a < 2; ++a)
#pragma unroll
        for (int b = 0; b < 2; ++b)
#pragma unroll
            for (int m = 0; m < 4; ++m)
#pragma unroll
                for (int n = 0; n < 2; ++n) acc[a][b][m][n] = (f32x4){0.f, 0.f, 0.f, 0.f};
    bf16x8 At[4][2], B0[2][2], B1[2][2];
    const char* cA = (const char*)g.A + (size_t)cur.pm * tstep; const char* cB = (const char*)g.Bt + (size_t)cur.pn * tstep;
    S.a_ready(cur);
    if constexpr (SP2) {
        PG8_STAGE(PG8_SB(0, 0), cB, voffB); PG8_STAGE(PG8_SB(0, 1), cB + hstep, voffB); PG8_STAGE(PG8_SA(0, 0), cA, voffA); PG8_STAGE(PG8_SA(0, 1), cA + hstep, voffA);
        if (wr == 1) PG8_BAR;
        PG8_WAIT_V(2); PG8_BAR;
        PG8_STAGE(PG8_SB(1, 0), cB + kstep, voffB); PG8_STAGE(PG8_SA(1, 0), cA + kstep, voffA); PG8_STAGE(PG8_SB(1, 1), cB + hstep + kstep, voffB);
        PG8_WAIT_V(6); PG8_BAR;
    } else {
        PG8_STAGE(PG8_SB(0, 0), cB, voffB); PG8_STAGE(PG8_SA(0, 0), cA, voffA); PG8_STAGE(PG8_SB(0, 1), cB + hstep, voffB); PG8_STAGE(PG8_SA(0, 1), cA + hstep, voffA);
        if (wr == 1) PG8_BAR;
        PG8_WAIT_V(4); PG8_BAR;
        PG8_STAGE(PG8_SB(1, 0), cB + kstep, voffB); PG8_STAGE(PG8_SA(1, 0), cA + kstep, voffA); PG8_STAGE(PG8_SB(1, 1), cB + hstep + kstep, voffB);
        PG8_WAIT_V(6); PG8_BAR;
    }
    for (;;) {
        const bool has_next = S.next(ui + 1, nxt);
        const char* nA = has_next ? (const char*)g.A + (size_t)nxt.pm * tstep : cA; const char* nB = has_next ? (const char*)g.Bt + (size_t)nxt.pn * tstep : cB;
        for (int t = 0; t < nt; t += 2) {
            const bool last = (t == nt - 2);
            const char* a1 = cA + (size_t)(t + 1) * kstep;
            const char* a2 = last ? nA : cA + (size_t)(t + 2) * kstep; const char* b2 = last ? nB : cB + (size_t)(t + 2) * kstep;
            const char* a3 = a2 + kstep; const char* b3 = b2 + kstep;
            if (last && has_next) S.a_ready(nxt);
            if constexpr (SP2) {
            PG8_LDB(B0, 0, 0); PG8_LDB(B1, 0, 1); PG8_SCHED; PG8_LDA(At, 0, 0); PG8_STAGE(PG8_SA(1, 1), a1 + hstep, voffA);
            PG8_WAIT_V(8); PG8_WAIT_L(0); PG8_BAR; PG8_MMA(0, 0, At, B0); PG8_MMA(0, 1, At, B1); PG8_BAR; PG8_SCHED;
            PG8_LDA(At, 0, 1); PG8_STAGE(PG8_SB(0, 0), b2, voffB); PG8_STAGE(PG8_SB(0, 1), b2 + hstep, voffB); PG8_STAGE(PG8_SA(0, 0), a2, voffA);
            PG8_WAIT_V(8); PG8_WAIT_L(0); PG8_BAR; PG8_MMA(1, 0, At, B0); PG8_MMA(1, 1, At, B1); PG8_BAR; PG8_SCHED;
            PG8_LDB(B0, 1, 0); PG8_LDB(B1, 1, 1); PG8_SCHED; PG8_LDA(At, 1, 0); PG8_STAGE(PG8_SA(0, 1), a2 + hstep, voffA);
            PG8_WAIT_V(8); PG8_WAIT_L(0); PG8_BAR; PG8_MMA(0, 0, At, B0); PG8_MMA(0, 1, At, B1); PG8_BAR; PG8_SCHED;
            PG8_LDA(At, 1, 1); PG8_STAGE(PG8_SB(1, 0), b3, voffB); PG8_STAGE(PG8_SB(1, 1), b3 + hstep, voffB); PG8_STAGE(PG8_SA(1, 0), a3, voffA);
            PG8_WAIT_V(8); PG8_WAIT_L(0); PG8_BAR; PG8_MMA(1, 0, At, B0); PG8_MMA(1, 1, At, B1); PG8_BAR; PG8_SCHED;
            } else {
            PG8_LDB(B0, 0, 0); PG8_SCHED; PG8_LDA(At, 0, 0); PG8_STAGE(PG8_SA(1, 1), a1 + hstep, voffA);
            PG8_WAIT_L(8); PG8_BAR; PG8_WAIT_L(0); PG8_MMA(0, 0, At, B0); PG8_BAR; PG8_SCHED;
            PG8_LDB(B1, 0, 1); PG8_STAGE(PG8_SB(0, 0), b2, voffB);
            PG8_BAR; PG8_WAIT_L(0); PG8_MMA(0, 1, At, B1); PG8_BAR;
            PG8_LDA(At, 0, 1); PG8_STAGE(PG8_SA(0, 0), a2, voffA);
            PG8_BAR; PG8_WAIT_L(0); PG8_MMA(1, 0, At, B0); PG8_BAR; PG8_SCHED;
            PG8_STAGE(PG8_SB(0, 1), b2 + hstep, voffB);
            PG8_WAIT_V(6); PG8_BAR; PG8_MMA(1, 1, At, B1); PG8_BAR;
            PG8_LDB(B0, 1, 0); PG8_SCHED; PG8_LDA(At, 1, 0); PG8_STAGE(PG8_SA(0, 1), a2 + hstep, voffA);
            PG8_WAIT_L(8); PG8_BAR; PG8_WAIT_L(0); PG8_MMA(0, 0, At, B0); PG8_BAR; PG8_SCHED;
            PG8_LDB(B1, 1, 1); PG8_STAGE(PG8_SB(1, 0), b3, voffB);
            PG8_BAR; PG8_WAIT_L(0); PG8_MMA(0, 1, At, B1); PG8_BAR;
            PG8_LDA(At, 1, 1); PG8_STAGE(PG8_SA(1, 0), a3, voffA);
            PG8_BAR; PG8_WAIT_L(0); PG8_MMA(1, 0, At, B0); PG8_BAR; PG8_SCHED;
            PG8_STAGE(PG8_SB(1, 1), b3 + hstep, voffB);
            PG8_WAIT_V(6); PG8_BAR; PG8_MMA(1, 1, At, B1); PG8_BAR;
            }
        }
        if constexpr (ALIGN_EPI) { if (wr == 0) PG8_BAR; }
        if constexpr (!Epi::AFTER_DRAIN) { E(acc, cur, wr, wc, fr, fq); S.done(cur); }
        if (!has_next) break;
#pragma unroll
        for (int a = 0; a < 2; ++a)
#pragma unroll
            for (int b = 0; b < 2; ++b)
#pragma unroll
                for (int m = 0; m < 4; ++m)
#pragma unroll
                    for (int n = 0; n < 2; ++n) acc[a][b][m][n] = (f32x4){0.f, 0.f, 0.f, 0.f};
        cur = nxt; cA = nA; cB = nB; ++ui;
        if constexpr (ALIGN_EPI) { if (wr == 1) PG8_BAR; }
    }
    PG8_WAIT_V(0);
    if constexpr (!ALIGN_EPI) { if (wr == 0) PG8_BAR; }
    PG8_BAR;
    if constexpr (Epi::AFTER_DRAIN) { E.fused(acc, cur, wr, wc, fr, fq, lds, wid, lane); S.done(cur); }
#undef PG8_SA
#undef PG8_SB
#undef PG8_STAGE
#undef PG8_LDA
#undef PG8_LDB
#undef PG8_MMA
#undef PG8_WAIT_V
#undef PG8_WAIT_L
#undef PG8_BAR
#undef PG8_SCHED
}
}

constexpr int DM = 1024, DV = 2048, DFF = 2816, NGV = 2 * DFF, NIN = 2 * DV;
constexpr int MP = 16384, MS = 512, MT = MP + MS;
constexpr int SEQ = 2048;
constexpr float EPS = 1e-6f;
constexpr int NWAVES = 8;
constexpr int NPHASE = 22;

constexpr size_t O_Y = 0, O_GV = 17301504, O_PP = 19398656, O_PS = 19644416, O_CP = 23576576, O_CS = 23756800, O_END = 26640384;

constexpr size_t MiB = 1u << 20;
constexpr size_t WS_CTL = 0, CTL_ZERO_BYTES = 65536;
constexpr size_t WS_RSS0 = 1 * MiB, WS_RSS1 = 3 * MiB;
constexpr size_t WS_VSS = 5 * MiB;
constexpr size_t WS_WIN = 8 * MiB, WS_WOUT = 24 * MiB, WS_WGV = 32 * MiB, WS_WDN = 76 * MiB, WS_WPL = 98 * MiB;
constexpr size_t WS_XB = 99 * MiB;
constexpr size_t WS_U = 132 * MiB, WS_V = 198 * MiB;
constexpr size_t WS_GT = WS_U;
constexpr size_t WS_TAIL = 224 * MiB, WS_HEAD = 230 * MiB;
constexpr size_t WS_XH = 244 * MiB;
constexpr size_t WS_END = 264 * MiB;

constexpr int LDS_BYTES = 155648;
constexpr int MISC_OFF = 155648 - 256;

#define GAS __attribute__((address_space(1)))
#define LAS __attribute__((address_space(3)))
typedef unsigned short bf16;
typedef unsigned v4u __attribute__((ext_vector_type(4)));
typedef unsigned v2u __attribute__((ext_vector_type(2)));
typedef float f32x4 __attribute__((ext_vector_type(4)));
typedef float f32x2 __attribute__((ext_vector_type(2)));
typedef short bf16x8 __attribute__((ext_vector_type(8)));
typedef __bf16 bf16x2_t __attribute__((ext_vector_type(2)));
#define LDS_WAIT() asm volatile("s_waitcnt lgkmcnt(0)" ::: "memory")
#define VM_WAIT() asm volatile("s_waitcnt vmcnt(0)" ::: "memory")

__device__ __forceinline__ unsigned pk2(float lo, float hi) { f32x2 v = {lo, hi}; bf16x2_t b = __builtin_convertvector(v, bf16x2_t); return __builtin_bit_cast(unsigned, b); }
__device__ __forceinline__ float bf_lo(unsigned w) { return __builtin_bit_cast(float, w << 16); }
__device__ __forceinline__ float bf_hi(unsigned w) { return __builtin_bit_cast(float, w & 0xffff0000u); }
__device__ __forceinline__ float wave_sum(float v) {
#pragma unroll
    for (int o = 1; o < 64; o <<= 1) v += __shfl_xor(v, o);
    return v;
}
__device__ __forceinline__ float sum4(f32x4 a) { return (a.x + a.y) + (a.z + a.w); }
__device__ __forceinline__ float dot4(f32x4 a) { return (a.x * a.x + a.y * a.y) + (a.z * a.z + a.w * a.w); }
__device__ __forceinline__ float rowscale16(const float* rss, int row) {
    const f32x4* p = (const f32x4*)(rss + (size_t)row * 16);
    const f32x4 a = p[0], b = p[1], c = p[2], d = p[3];
    const float s = (sum4(a) + sum4(b)) + (sum4(c) + sum4(d));
    return __builtin_amdgcn_rsqf(s * (1.0f / 1024.0f) + EPS);
}
__device__ __forceinline__ float gelu_t(float x) {
    const float e = __builtin_amdgcn_exp2f(x * (-2.3022082f + -0.1029432f * x * x));
    return x * __builtin_amdgcn_rcpf(1.0f + e);
}
__device__ __forceinline__ float silu_f(float x) {
    const float e = __builtin_amdgcn_exp2f(x * -1.4426950409f);
    return x * __builtin_amdgcn_rcpf(1.0f + e);
}
template <int CTRL> __device__ __forceinline__ float dppf(float old, float src) {
    return __builtin_bit_cast(float, __builtin_amdgcn_update_dpp(__builtin_bit_cast(int, old), __builtin_bit_cast(int, src), CTRL, 0xf, 0xf, false));
}


struct EpiG1 {
    static constexpr bool PERM = true, AFTER_DRAIN = false;
    bf16* U; bf16* V; const float* rss; float* vss;
    __device__ __forceinline__ void operator()(const f32x4 (&acc)[2][2][4][2], const pg8::Unit& u, int wr, int wc, int fr, int fq) const {
        const bool isv = u.pn >= 8;
        bf16* base = isv ? V : U;
        const int col0 = (u.pn & 7) * 256 + wc * 32 + 8 * fq;
#pragma unroll
        for (int ai = 0; ai < 2; ++ai)
#pragma unroll
            for (int m = 0; m < 4; ++m) {
                const int row = u.pm * 256 + ai * 128 + wr * 64 + m * 16 + fr;
                const float rr = rowscale16(rss, row);
                float ss = 0.f;
                bf16* rowp = base + (size_t)row * DV + col0;
#pragma unroll
                for (int bj = 0; bj < 2; ++bj) {
                    f32x4 v0 = acc[ai][bj][m][0] * rr, v1 = acc[ai][bj][m][1] * rr;
#pragma unroll
                    for (int j = 0; j < 4; ++j) { v0[j] = gelu_t(v0[j]); v1[j] = gelu_t(v1[j]); }
                    ss += dot4(v0) + dot4(v1);
                    v4u w; w.x = pk2(v0[0], v0[1]); w.y = pk2(v0[2], v0[3]); w.z = pk2(v1[0], v1[1]); w.w = pk2(v1[2], v1[3]);
                    *(v4u*)(rowp + bj * 128) = w;
                }
                if (isv) {
                    ss += __shfl_xor(ss, 16); ss += __shfl_xor(ss, 32);
                    if (fq == 0) vss[(size_t)row * 32 + (u.pn - 8) * 4 + wc] = ss;
                }
            }
    }
};

struct EpiRes {
    static constexpr bool PERM = false, AFTER_DRAIN = false;
    float* X; bf16* XB; float* rss_out; float* xh;
    __device__ __forceinline__ void operator()(const f32x4 (&acc)[2][2][4][2], const pg8::Unit& u, int wr, int wc, int fr, int fq) const {
        const int col0 = u.pn * 256 + wc * 32 + 4 * fq;
#pragma unroll
        for (int ai = 0; ai < 2; ++ai)
#pragma unroll
            for (int m = 0; m < 4; ++m) {
                const int row = u.pm * 256 + ai * 128 + wr * 64 + m * 16 + fr;
                float* xr = X + (size_t)row * DM + col0; bf16* br = XB + (size_t)row * DM + col0;
                float ss = 0.f;
                const bool hal = xh != nullptr && (row & 127) >= 113;
                float* hr = xh + ((size_t)(row >> 7) * 15 + ((row & 127) - 113)) * DM + col0;
#pragma unroll
                for (int bj = 0; bj < 2; ++bj)
#pragma unroll
                    for (int n = 0; n < 2; ++n) {
                        const int o = bj * 128 + n * 16;
                        f32x4 x = *(const f32x4*)(xr + o); x += acc[ai][bj][m][n];
                        *(f32x4*)(xr + o) = x; ss += dot4(x);
                        v2u w; w.x = pk2(x[0], x[1]); w.y = pk2(x[2], x[3]); *(v2u*)(br + o) = w;
                        if (hal) *(f32x4*)(hr + o) = x;
                    }
                ss += __shfl_xor(ss, 16); ss += __shfl_xor(ss, 32);
                if (fq == 0) rss_out[(size_t)row * 16 + u.pn * 4 + wc] = ss;
            }
    }
};

struct EpiGate {
    static constexpr bool PERM = true, AFTER_DRAIN = false;
    bf16* GT; const float* rss; const float* cw; const float* cb; float* tail; float* head; const float* state; float* out_cp; float* out_cs;
    __device__ __forceinline__ void operator()(const f32x4 (&acc)[2][2][4][2], const pg8::Unit& u, int wr, int wc, int fr, int fq) const {
        const int f0 = u.pn * 128 + wc * 32 + 8 * fq;
        float w0[8], w1[8], w2[8], bb[8];
#pragma unroll
        for (int h = 0; h < 2; ++h) {
            const f32x4 a = *(const f32x4*)(cw + f0 + 4 * h), b = *(const f32x4*)(cw + DFF + f0 + 4 * h), c = *(const f32x4*)(cw + 2 * DFF + f0 + 4 * h), d = *(const f32x4*)(cb + f0 + 4 * h);
#pragma unroll
            for (int j = 0; j < 4; ++j) { w0[4 * h + j] = a[j]; w1[4 * h + j] = b[j]; w2[4 * h + j] = c[j]; bb[4 * h + j] = d[j]; }
        }
        const bool prompt = u.pm < 64;
#pragma unroll
        for (int ai = 0; ai < 2; ++ai) {
            float prev[8];
#pragma unroll
            for (int k = 0; k < 8; ++k) prev[k] = 0.f;
#pragma unroll
            for (int m = 0; m < 4; ++m) {
                const int row = u.pm * 256 + ai * 128 + wr * 64 + m * 16 + fr;
                const float rr = rowscale16(rss, row);
                float a[8], v[8], a1[8], a2[8];
#pragma unroll
                for (int n = 0; n < 2; ++n)
#pragma unroll
                    for (int j = 0; j < 4; ++j) { a[4 * n + j] = acc[ai][0][m][n][j] * rr; v[4 * n + j] = acc[ai][1][m][n][j] * rr; }
                if (prompt) {
#pragma unroll
                    for (int k = 0; k < 8; ++k) {
                        const float t1 = dppf<0x121>(0.f, prev[k]), t2 = dppf<0x122>(0.f, prev[k]);
                        a1[k] = dppf<0x111>(t1, a[k]);
                        a2[k] = dppf<0x112>(t2, a[k]);
                    }
                } else {
                    const int bs = (row - MP) >> 2, t = fr & 3;
                    const float* s0p = state + ((size_t)bs * 2 + 0) * DFF + f0; const float* s1p = s0p + DFF;
                    const f32x4 s0a = *(const f32x4*)s0p, s0b = *(const f32x4*)(s0p + 4), s1a = *(const f32x4*)s1p, s1b = *(const f32x4*)(s1p + 4);
#pragma unroll
                    for (int k = 0; k < 8; ++k) {
                        const float s0 = k < 4 ? s0a[k & 3] : s0b[k & 3], s1 = k < 4 ? s1a[k & 3] : s1b[k & 3];
                        const float x1 = dppf<0x111>(0.f, a[k]), x2 = dppf<0x112>(0.f, a[k]);
                        a1[k] = (t == 0) ? s1 : x1;
                        a2[k] = (t == 0) ? s0 : ((t == 1) ? s1 : x2);
                    }
                }
                float g[8];
#pragma unroll
                for (int k = 0; k < 8; ++k) { const float cv = bb[k] + w0[k] * a2[k] + w1[k] * a1[k] + w2[k] * a[k]; g[k] = silu_f(cv) * v[k]; }
                v4u w; w.x = pk2(g[0], g[1]); w.y = pk2(g[2], g[3]); w.z = pk2(g[4], g[5]); w.w = pk2(g[6], g[7]);
                *(v4u*)(GT + (size_t)row * DFF + f0) = w;
                const f32x4 alo = {a[0], a[1], a[2], a[3]}, ahi = {a[4], a[5], a[6], a[7]};
                if (prompt) {
                    const int G = row >> 6;
                    if (m == 0 && fr < 2) {
                        float* hp = head + ((size_t)G * 4 + fr) * DFF + f0;
                        *(f32x4*)hp = alo; *(f32x4*)(hp + 4) = ahi;
                        const f32x4 vlo = {v[0], v[1], v[2], v[3]}, vhi = {v[4], v[5], v[6], v[7]};
                        *(f32x4*)(hp + 2 * DFF) = vlo; *(f32x4*)(hp + 2 * DFF + 4) = vhi;
                    }
                    if (m == 3 && fr >= 14) {
                        float* tp = tail + ((size_t)G * 2 + (fr - 14)) * DFF + f0;
                        *(f32x4*)tp = alo; *(f32x4*)(tp + 4) = ahi;
                        if ((row & (SEQ - 1)) >= SEQ - 2) {
                            float* op = out_cp + ((size_t)(row >> 11) * 2 + (fr - 14)) * DFF + f0;
                            *(f32x4*)op = alo; *(f32x4*)(op + 4) = ahi;
                        }
                    }
                } else {
                    const int t = fr & 3;
                    if (t >= 2) { float* op = out_cs + ((size_t)((row - MP) >> 2) * 2 + (t - 2)) * DFF + f0; *(f32x4*)op = alo; *(f32x4*)(op + 4) = ahi; }
                }
#pragma unroll
                for (int k = 0; k < 8; ++k) prev[k] = a[k];
            }
        }
    }
};
#define XB_TMO      128
#define XB_XCNT(j)  (256  + 64 * (j))
#define XB_XSUB(j)  (1280 + 64 * (j))
#define XB_XGEN(j)  (2304 + 64 * (j))
#define XB_TOP      3328
#define XB_TOPGEN   3392
#define XCD_BAR_WORDS 3456
#define XB_SPIN_CAP (1u << 18)

__device__ __forceinline__ unsigned xb_ld(unsigned* p)              { return __hip_atomic_load(p, __ATOMIC_RELAXED, __HIP_MEMORY_SCOPE_AGENT); }
__device__ __forceinline__ unsigned xb_add(unsigned* p, unsigned v) { return __hip_atomic_fetch_add(p, v, __ATOMIC_RELAXED, __HIP_MEMORY_SCOPE_AGENT); }
__device__ __forceinline__ unsigned xb_xcc_id() { return (unsigned)__builtin_amdgcn_s_getreg((3 << 11) | 20) & 0xFu; }
#define XB_SPIN(cond, bar) do { unsigned _sp = 0; while (cond) { __builtin_amdgcn_s_sleep(1); \
    if ((++_sp & 255u) == 0u) { if (xb_ld(&(bar)[XB_TMO])) break; if (_sp > XB_SPIN_CAP) { atomicAdd(&(bar)[XB_TMO], 1u); break; } } } } while (0)

struct XcdBarrier {
    unsigned* bar; unsigned x;
    volatile LAS unsigned* st;
};

__device__ __forceinline__ XcdBarrier xcd_barrier_post(unsigned* bar, volatile LAS unsigned* st) {
    XcdBarrier b; b.bar = bar; b.x = xb_xcc_id(); b.st = st;
    if (threadIdx.x == 0) (void)xb_add(&bar[XB_XCNT(b.x)], 1u);
    return b;
}
__device__ __forceinline__ void xcd_barrier_complete(unsigned* bar, unsigned x, unsigned& nloc, unsigned& nx) {
    const unsigned G = gridDim.x * gridDim.y * gridDim.z;
    unsigned sum, cnt, mine, sp = 0u;
    for (;;) {
        sum = 0u; cnt = 0u; mine = 0u;
#pragma unroll
        for (unsigned j = 0; j < 16; ++j) { const unsigned c = xb_ld(&bar[XB_XCNT(j)]); sum += c; cnt += (c > 0u) ? 1u : 0u; mine = (j == x) ? c : mine; }
        if (sum == G) break;
        __builtin_amdgcn_s_sleep(1);
        if ((++sp & 255u) == 0u) { if (xb_ld(&bar[XB_TMO])) break; if (sp > XB_SPIN_CAP) { atomicAdd(&bar[XB_TMO], 1u); break; } }
    }
    nloc = mine > 0u ? mine : 1u; nx = cnt > 0u ? cnt : 1u;
}

__device__ __forceinline__ void xcd_barrier(const XcdBarrier& b) {
    asm volatile("s_waitcnt vmcnt(0)" ::: "memory");
    __syncthreads();
    if (threadIdx.x == 0) {
        unsigned* bar = b.bar;
        __builtin_amdgcn_s_waitcnt(0);
        unsigned nloc = b.st[0], nx = b.st[1];
        if (nloc == 0u) { xcd_barrier_complete(bar, b.x, nloc, nx); b.st[0] = nloc; b.st[1] = nx; }
        const unsigned old = xb_add(&bar[XB_XSUB(b.x)], 1u);
        const unsigned gen = old / nloc;
        if (old + 1u == (gen + 1u) * nloc) {
            __builtin_amdgcn_fence(__ATOMIC_RELEASE, "agent");
            asm volatile("s_waitcnt vmcnt(0)" ::: "memory");
            const unsigned og = xb_add(&bar[XB_TOP], 1u);
            const unsigned tg = og / nx;
            if (og + 1u == (tg + 1u) * nx) xb_add(&bar[XB_TOPGEN], 1u);
            else XB_SPIN(xb_ld(&bar[XB_TOPGEN]) == tg, bar);
            __builtin_amdgcn_fence(__ATOMIC_ACQUIRE, "agent");
            xb_add(&bar[XB_XGEN(b.x)], 1u);
            asm volatile("s_waitcnt vmcnt(0)" ::: "memory");
        } else {
            XB_SPIN(xb_ld(&bar[XB_XGEN(b.x)]) == gen, bar);
            __builtin_amdgcn_fence(__ATOMIC_ACQUIRE, "agent");
            asm volatile("s_waitcnt vmcnt(0)" ::: "memory");
        }
    }
    __syncthreads();
}

struct Args { const float* in[19]; float* out; unsigned char* ws; int ph_lo, ph_hi, use_bar, pad; };
enum { I_XP = 0, I_XS, I_SPOOL, I_SCONV, I_NMIX, I_NFFN, I_NFIN, I_WIN, I_GV, I_WS, I_BS, I_WOUT, I_WPOOL, I_SCALE, I_WGATE, I_WVAL, I_CW, I_CB, I_WDOWN };

__device__ __forceinline__ void transpose_item(const float* W, int ldw, int K, bf16* WT, int wt_row0, const float* gk, LAS float* scr, int kb, int nb, int lane) {
    const int k0 = 64 * kb, n0 = 32 * nb;
#pragma unroll 8
    for (int i = 0; i < 32; ++i) { const int kk = 2 * i + (lane >> 5); scr[kk * 33 + (lane & 31)] = W[(size_t)(k0 + kk) * ldw + n0 + (lane & 31)]; }
    LDS_WAIT(); asm volatile("" ::: "memory");
    const int c = lane & 7;
    float g[8];
#pragma unroll
    for (int t = 0; t < 8; ++t) g[t] = gk ? gk[k0 + 8 * c + t] : 1.0f;
#pragma unroll
    for (int j = 0; j < 4; ++j) { const int n = (lane >> 3) + 8 * j; const LAS float* s = scr + (8 * c) * 33 + n;
        v4u o; o.x = pk2(s[0 * 33] * g[0], s[1 * 33] * g[1]); o.y = pk2(s[2 * 33] * g[2], s[3 * 33] * g[3]); o.z = pk2(s[4 * 33] * g[4], s[5 * 33] * g[5]); o.w = pk2(s[6 * 33] * g[6], s[7 * 33] * g[7]);
        *(v4u*)(WT + (size_t)(wt_row0 + n) * K + k0 + 8 * c) = o; }
    LDS_WAIT(); asm volatile("" ::: "memory");
}

__device__ __forceinline__ void phase_prologue(const Args& A, LAS unsigned char* lds, int G) {
    int tid_ = threadIdx.x; asm volatile("" : "+v"(tid_)); const int tid = tid_, lane = tid & 63, wave = __builtin_amdgcn_readfirstlane(tid >> 6);
    LAS float* scr = (LAS float*)(lds + wave * 16384);
    const int gw = blockIdx.x * NWAVES + wave, NGW = G * NWAVES;
    bf16* WIN = (bf16*)(A.ws + WS_WIN); bf16* WOUT = (bf16*)(A.ws + WS_WOUT); bf16* WGV = (bf16*)(A.ws + WS_WGV); bf16* WDN = (bf16*)(A.ws + WS_WDN); bf16* WPL = (bf16*)(A.ws + WS_WPL);
    constexpr int N_IN = 2 * 2048, N_OUT = 2 * 1024, N_GV = 4 * 2816, N_DN = 4 * 1408, N_PL = 8 * 32, NITEMS = N_IN + N_OUT + N_GV + N_DN + N_PL;
    for (int it = gw; it < NITEMS; it += NGW) {
        int r = it;
        if (r < N_IN) { const int j = r / 2048; r %= 2048; const int kb = r / 128, nb = r % 128;
            transpose_item(A.in[I_WIN] + (size_t)j * DM * NIN, NIN, DM, WIN + (size_t)j * NIN * DM, 32 * nb, A.in[I_NMIX] + (2 * j) * DM, scr, kb, nb, lane); continue; }
        r -= N_IN;
        if (r < N_OUT) { const int j = r / 1024; r %= 1024; const int kb = r / 32, nb = r % 32;
            transpose_item(A.in[I_WOUT] + (size_t)j * DV * DM, DM, DV, WOUT + (size_t)j * DM * DV, 32 * nb, nullptr, scr, kb, nb, lane); continue; }
        r -= N_OUT;
        if (r < N_GV) { const int i = r / 2816; r %= 2816; const int isval = r / 1408; r %= 1408; const int kb = r / 88, nb = r % 88; const int f0 = 32 * nb;
            transpose_item((isval ? A.in[I_WVAL] : A.in[I_WGATE]) + (size_t)i * DM * DFF, DFF, DM, WGV + (size_t)i * NGV * DM, 256 * (f0 >> 7) + 128 * isval + (f0 & 127), A.in[I_NFFN] + i * DM, scr, kb, nb, lane); continue; }
        r -= N_GV;
        if (r < N_DN) { const int i = r / 1408; r %= 1408; const int kb = r / 32, nb = r % 32;
            transpose_item(A.in[I_WDOWN] + (size_t)i * DFF * DM, DM, DFF, WDN + (size_t)i * DM * DFF, 32 * nb, nullptr, scr, kb, nb, lane); continue; }
        r -= N_DN;
        { const int jg = r / 32; r %= 32; const int kb = r / 8, nb = r % 8;
            transpose_item(A.in[I_WPOOL] + (size_t)jg * 65536, 256, 256, WPL + (size_t)jg * 65536, 32 * nb, nullptr, scr, kb, nb, lane); }
    }
    float* X = A.out + O_Y; bf16* XB = (bf16*)(A.ws + WS_XB); float* rss0 = (float*)(A.ws + WS_RSS0);
    for (int m = gw; m < MT; m += NGW) {
        const float* src = m < MP ? A.in[I_XP] + (size_t)m * DM : A.in[I_XS] + (size_t)(m - MP) * DM;
        f32x4 v[4]; float ss[4];
#pragma unroll
        for (int j = 0; j < 4; ++j) { v[j] = *(const f32x4*)(src + 256 * j + 4 * lane); ss[j] = wave_sum(dot4(v[j])); }
#pragma unroll
        for (int j = 0; j < 4; ++j) { *(f32x4*)(X + (size_t)m * DM + 256 * j + 4 * lane) = v[j]; v2u w; w.x = pk2(v[j][0], v[j][1]); w.y = pk2(v[j][2], v[j][3]); *(v2u*)(XB + (size_t)m * DM + 256 * j + 4 * lane) = w; }
        if (lane < 16) { const int q = lane >> 2; const float s = q == 0 ? ss[0] : (q == 1 ? ss[1] : (q == 2 ? ss[2] : ss[3])); rss0[(size_t)m * 16 + lane] = (lane & 3) == 0 ? s : 0.f; }
    }
    { const f32x4* sp = (const f32x4*)A.in[I_SPOOL]; f32x4* op = (f32x4*)(A.out + O_PS);
      const size_t tot = (size_t)256 * 2816, stride = (size_t)G * 512;
      for (size_t i = (size_t)blockIdx.x * 512 + tid; i < tot; i += stride) { const size_t jb = i / 2816, r = i % 2816; op[jb * 3840 + r] = sp[jb * 3840 + 1024 + r]; } }
}

__device__ __forceinline__ void phase_spatial(const Args& A, LAS unsigned char* lds, int G, int jl) {
    int tid_ = threadIdx.x; asm volatile("" : "+v"(tid_)); const int tid = tid_, lane = tid & 63, wave = __builtin_amdgcn_readfirstlane(tid >> 6), fr = lane & 15, fq = lane >> 4;
    LAS bf16* VT = (LAS bf16*)lds;
    LAS bf16* WM = (LAS bf16*)(lds + 69632);
    LAS float* RV = (LAS float*)(lds + 104448);
    bf16* U = (bf16*)(A.ws + WS_U); const bf16* V = (const bf16*)(A.ws + WS_V); const float* vss = (const float*)(A.ws + WS_VSS);
    const float* wsm = A.in[I_WS] + (size_t)jl * 8 * 16384; const float* bsv = A.in[I_BS] + jl * 8 * 128; const float* gv = A.in[I_GV] + jl * DV;
    float* ogv = A.out + O_GV + (size_t)jl * MS * DV;
    for (int item = blockIdx.x; item < 132 * 8; item += G) {
        const int c = item >> 3, h = item & 7, R0 = 128 * c; const bool sample = c >= 128;
        if (tid < 128) { const f32x4* p = (const f32x4*)(vss + (size_t)(R0 + tid) * 32); float s = 0.f;
#pragma unroll
            for (int q = 0; q < 8; ++q) s += sum4(p[q]);
            RV[tid] = __builtin_amdgcn_rsqf(s * (1.0f / 2048.0f) + EPS); }
        __syncthreads();
        const float* wh = wsm + (size_t)h * 16384;
        for (int idx = tid; idx < 16384; idx += 512) { const int i = idx >> 7, j = idx & 127; float w;
            if (!sample) w = (j <= i) ? wh[i * 128 + j] : 0.f;
            else w = ((i >> 2) == (j >> 2) && (j & 3) <= (i & 3)) ? wh[(i & 3) * 128 + (j & 3)] : 0.f;
            WM[i * 136 + j] = (bf16)(pk2(w * RV[j], 0.f) & 0xffffu); }
        for (int idx = tid; idx < 4096; idx += 512) { const int j = idx >> 5, e8 = (idx & 31) * 8;
            const v4u v = *(const v4u*)(V + (size_t)(R0 + j) * DV + 256 * h + e8);
            LAS bf16* d = VT + e8 * 136 + j;
            d[0 * 136] = (bf16)(v.x & 0xffffu); d[1 * 136] = (bf16)(v.x >> 16); d[2 * 136] = (bf16)(v.y & 0xffffu); d[3 * 136] = (bf16)(v.y >> 16);
            d[4 * 136] = (bf16)(v.z & 0xffffu); d[5 * 136] = (bf16)(v.z >> 16); d[6 * 136] = (bf16)(v.w & 0xffffu); d[7 * 136] = (bf16)(v.w >> 16); }
        __syncthreads();
        f32x4 acc[8][2];
#pragma unroll
        for (int rb = 0; rb < 8; ++rb) { acc[rb][0] = (f32x4){0.f, 0.f, 0.f, 0.f}; acc[rb][1] = (f32x4){0.f, 0.f, 0.f, 0.f}; }
#pragma unroll
        for (int ks = 0; ks < 4; ++ks) {
            bf16x8 bfr[2];
#pragma unroll
            for (int cb = 0; cb < 2; ++cb) bfr[cb] = *(const LAS bf16x8*)(VT + (32 * wave + 16 * cb + fr) * 136 + 32 * ks + 8 * fq);
#pragma unroll
            for (int rb = 0; rb < 8; ++rb) { const bf16x8 afr = *(const LAS bf16x8*)(WM + (16 * rb + fr) * 136 + 32 * ks + 8 * fq);
                acc[rb][0] = __builtin_amdgcn_mfma_f32_16x16x32_bf16(bfr[0], afr, acc[rb][0], 0, 0, 0);
                acc[rb][1] = __builtin_amdgcn_mfma_f32_16x16x32_bf16(bfr[1], afr, acc[rb][1], 0, 0, 0); }
        }
#pragma unroll
        for (int rb = 0; rb < 8; ++rb) { const int i = 16 * rb + fr, row = R0 + i; const float bi = bsv[h * 128 + (sample ? (i & 3) : i)];
#pragma unroll
            for (int cb = 0; cb < 2; ++cb) { const int e = 256 * h + 32 * wave + 16 * cb + 4 * fq;
                const f32x4 g4 = *(const f32x4*)(gv + e); bf16* up = U + (size_t)row * DV + e; const v2u uu = *(const v2u*)up;
                const f32x4 s = g4 * acc[rb][cb] + bi;
                v2u w; w.x = pk2(bf_lo(uu.x) * s[0], bf_hi(uu.x) * s[1]); w.y = pk2(bf_lo(uu.y) * s[2], bf_hi(uu.y) * s[3]);
                *(v2u*)up = w; } }
        if (sample) {
            for (int idx = tid; idx < 4096; idx += 512) { const int j = idx >> 5, e8 = (idx & 31) * 8; const int e = 256 * h + e8;
                const v4u v = *(const v4u*)(V + (size_t)(R0 + j) * DV + e); const float rv = RV[j];
                const f32x4 ga = *(const f32x4*)(gv + e), gb = *(const f32x4*)(gv + e + 4);
                float* o = ogv + (size_t)(R0 - MP + j) * DV + e;
                *(f32x4*)o = (f32x4){bf_lo(v.x) * rv * ga[0], bf_hi(v.x) * rv * ga[1], bf_lo(v.y) * rv * ga[2], bf_hi(v.y) * rv * ga[3]};
                *(f32x4*)(o + 4) = (f32x4){bf_lo(v.z) * rv * gb[0], bf_hi(v.z) * rv * gb[1], bf_lo(v.w) * rv * gb[2], bf_hi(v.w) * rv * gb[3]}; }
        }
        __syncthreads();
    }
}

__device__ __forceinline__ void phase_fixup(const Args& A, int G, int layer) {
    const float* tail = (const float*)(A.ws + WS_TAIL); const float* head = (const float*)(A.ws + WS_HEAD); bf16* GT = (bf16*)(A.ws + WS_GT);
    const float* cw = A.in[I_CW] + (size_t)layer * 3 * DFF; const float* cb = A.in[I_CB] + (size_t)layer * DFF;
    const int tot = 256 * 2 * 704;
    for (int idx = blockIdx.x * 512 + threadIdx.x; idx < tot; idx += G * 512) {
        const int Gr = idx / 1408, rem = idx % 1408, r = rem / 704, f = 4 * (rem % 704);
        if ((Gr & 31) == 0) continue;
        const f32x4 t0 = *(const f32x4*)(tail + ((size_t)(Gr - 1) * 2 + 0) * DFF + f), t1 = *(const f32x4*)(tail + ((size_t)(Gr - 1) * 2 + 1) * DFF + f);
        const f32x4 h0 = *(const f32x4*)(head + ((size_t)Gr * 4 + 0) * DFF + f), h1 = *(const f32x4*)(head + ((size_t)Gr * 4 + 1) * DFF + f);
        const f32x4 vv = *(const f32x4*)(head + ((size_t)Gr * 4 + 2 + r) * DFF + f);
        const f32x4 w0 = *(const f32x4*)(cw + f), w1 = *(const f32x4*)(cw + DFF + f), w2 = *(const f32x4*)(cw + 2 * DFF + f), bb = *(const f32x4*)(cb + f);
        const f32x4 cv = r == 0 ? bb + w0 * t0 + w1 * t1 + w2 * h0 : bb + w0 * t1 + w1 * h0 + w2 * h1;
        v2u w; w.x = pk2(silu_f(cv[0]) * vv[0], silu_f(cv[1]) * vv[1]); w.y = pk2(silu_f(cv[2]) * vv[2], silu_f(cv[3]) * vv[3]);
        *(v2u*)(GT + (size_t)(64 * Gr + r) * DFF + f) = w;
    }
}

__device__ __forceinline__ void phase_pool(const Args& A, LAS unsigned char* lds, int G, int layer, const float* rss_in, float* rss_out) {
    int tid_ = threadIdx.x; asm volatile("" : "+v"(tid_)); const int tid = tid_, lane = tid & 63, wave = __builtin_amdgcn_readfirstlane(tid >> 6), fr = lane & 15, fq = lane >> 4;
    const int jl = layer >> 1;
    LAS float* H = (LAS float*)lds;
    LAS float* RR = (LAS float*)(lds + 143 * 1024);
    float* X = A.out + O_Y; bf16* XB = (bf16*)(A.ws + WS_XB); const float* XH = (const float*)(A.ws + WS_XH);
    const float* gain = A.in[I_NMIX] + (size_t)layer * DM; const float* scale = A.in[I_SCALE] + (size_t)jl * DM;
    const bf16* WPL = (const bf16*)(A.ws + WS_WPL) + (size_t)jl * 4 * 65536;
    const float* spool = A.in[I_SPOOL] + (size_t)jl * 128 * 15 * DM;
    float* opp = A.out + O_PP + (size_t)jl * 8 * 15 * DM; float* ops = A.out + O_PS + (size_t)jl * 128 * 15 * DM;
    for (int item = blockIdx.x; item < 132 * 4; item += G) {
        const int tm = item >> 2, g = item & 3, R0 = 128 * tm; const bool sample = tm >= 128;
        const int W = 2 << g;
        const bf16* wp = WPL + (size_t)g * 65536;
        if (tid < 143) { const int grow = R0 - 15 + tid; RR[tid] = (grow >= 0 && (!sample || tid >= 15)) ? rowscale16(rss_in, grow) : 0.f; }
        __syncthreads();
        if (!sample) {
            const bool seq_start = (R0 & (SEQ - 1)) == 0, seq_end = (R0 & (SEQ - 1)) == SEQ - 128;
            for (int idx = tid; idx < 143 * 64; idx += 512) { const int hi = idx >> 6, c4 = (idx & 63) * 4, ch = 256 * g + c4;
                f32x4 x;
                if (hi >= 15) x = *(const f32x4*)(X + (size_t)(R0 - 15 + hi) * DM + ch);
                else if (seq_start) x = (f32x4){0.f, 0.f, 0.f, 0.f};
                else x = *(const f32x4*)(XH + ((size_t)(tm - 1) * 15 + hi) * DM + ch);
                const f32x4 gg = *(const f32x4*)(gain + ch);
                const f32x4 hv = x * RR[hi] * gg;
                *(LAS f32x4*)(H + hi * 256 + c4) = hv;
                if (seq_end && hi >= 128) *(f32x4*)(opp + ((size_t)(R0 >> 11) * 15 + (hi - 128)) * DM + ch) = hv;
            }
            __syncthreads();
        }
        f32x4 acc[16];
#pragma unroll
        for (int cb = 0; cb < 16; ++cb) acc[cb] = (f32x4){0.f, 0.f, 0.f, 0.f};
        const int i = 16 * wave + fr;
#pragma unroll 1
        for (int ks = 0; ks < 8; ++ks) {
            const int c8 = 32 * ks + 8 * fq;
            f32x4 s0 = {0.f, 0.f, 0.f, 0.f}, s1 = {0.f, 0.f, 0.f, 0.f}, h0, h1;
            float inv;
            if (!sample) {
                const int hi = i + 15; const int t = (R0 + i) & (SEQ - 1); const int cnt = (t + 1) < W ? (t + 1) : W;
                for (int d = 0; d < W; ++d) { s0 += *(const LAS f32x4*)(H + (hi - d) * 256 + c8); s1 += *(const LAS f32x4*)(H + (hi - d) * 256 + c8 + 4); }
                h0 = *(const LAS f32x4*)(H + hi * 256 + c8); h1 = *(const LAS f32x4*)(H + hi * 256 + c8 + 4);
                inv = 1.0f / (float)cnt;
            } else {
                const int srow = R0 - MP + i, b = srow >> 2, t = srow & 3, ch = 256 * g + c8;
                const f32x4 ga = *(const f32x4*)(gain + ch), gb = *(const f32x4*)(gain + ch + 4);
                h0 = (f32x4){0.f, 0.f, 0.f, 0.f}; h1 = h0;
                for (int d = 0; d < W; ++d) { const int k = t - d; f32x4 a, bq;
                    if (k >= 0) { const float rr = RR[15 + i - d]; const float* xp = X + (size_t)(R0 + i - d) * DM + ch; a = *(const f32x4*)xp * rr * ga; bq = *(const f32x4*)(xp + 4) * rr * gb; }
                    else { const float* sp = spool + ((size_t)b * 15 + (15 + k)) * DM + ch; a = *(const f32x4*)sp; bq = *(const f32x4*)(sp + 4); }
                    if (d == 0) { h0 = a; h1 = bq; }
                    s0 += a; s1 += bq; }
                inv = 1.0f / (float)W;
                float* o = ops + ((size_t)b * 15 + 11 + t) * DM + ch; *(f32x4*)o = h0; *(f32x4*)(o + 4) = h1;
            }
            const f32x4 p0 = s0 * inv - h0, p1 = s1 * inv - h1;
            v4u pw; pw.x = pk2(p0[0], p0[1]); pw.y = pk2(p0[2], p0[3]); pw.z = pk2(p1[0], p1[1]); pw.w = pk2(p1[2], p1[3]);
            const bf16x8 afr = __builtin_bit_cast(bf16x8, pw);
#pragma unroll
            for (int cb = 0; cb < 16; ++cb) { const bf16x8 bfr = *(const bf16x8*)(wp + (size_t)(16 * cb + fr) * 256 + c8);
                acc[cb] = __builtin_amdgcn_mfma_f32_16x16x32_bf16(bfr, afr, acc[cb], 0, 0, 0); }
        }
        { const int row = R0 + i; float ss = 0.f;
#pragma unroll
          for (int cb = 0; cb < 16; ++cb) { const int ch = 256 * g + 16 * cb + 4 * fq; const f32x4 sc = *(const f32x4*)(scale + ch);
              float* xp = X + (size_t)row * DM + ch; f32x4 x = *(const f32x4*)xp; x += acc[cb] * sc; *(f32x4*)xp = x; ss += dot4(x);
              v2u w; w.x = pk2(x[0], x[1]); w.y = pk2(x[2], x[3]); *(v2u*)(XB + (size_t)row * DM + ch) = w; }
          ss += __shfl_xor(ss, 16); ss += __shfl_xor(ss, 32);
          rss_out[(size_t)row * 16 + g * 4 + fq] = fq == 0 ? ss : 0.f; }
        __syncthreads();
    }
}

__device__ __forceinline__ void phase_final(const Args& A, int G) {
    int tid_ = threadIdx.x; asm volatile("" : "+v"(tid_)); const int tid = tid_, lane = tid & 63, wave = __builtin_amdgcn_readfirstlane(tid >> 6);
    float* X = A.out + O_Y; const float* gf = A.in[I_NFIN];
    for (int m = blockIdx.x * NWAVES + wave; m < MT; m += G * NWAVES) {
        f32x4 v[4]; float s = 0.f;
#pragma unroll
        for (int j = 0; j < 4; ++j) { v[j] = *(const f32x4*)(X + (size_t)m * DM + 256 * j + 4 * lane); s += dot4(v[j]); }
        const float rr = __builtin_amdgcn_rsqf(wave_sum(s) * (1.0f / 1024.0f) + EPS);
#pragma unroll
        for (int j = 0; j < 4; ++j) { const f32x4 gg = *(const f32x4*)(gf + 256 * j + 4 * lane); *(f32x4*)(X + (size_t)m * DM + 256 * j + 4 * lane) = v[j] * rr * gg; }
    }
}

enum { T_PRO = 0, T_G1, T_SP, T_G3, T_G5, T_FX, T_G6, T_PL, T_FIN };
#ifndef PHASE_MASK
#define PHASE_MASK 255
#endif
#ifndef N_LAUNCH_SPLIT
#define N_LAUNCH_SPLIT 0
#endif

__global__ void __launch_bounds__(NWAVES * 64, 2) fwd_kernel(Args args) {
    extern __shared__ __attribute__((aligned(16))) unsigned char lds_raw[];
    LAS unsigned char* lds = (LAS unsigned char*)lds_raw;
    volatile LAS unsigned* MISC = (volatile LAS unsigned*)(lds + MISC_OFF);
    const int tid = threadIdx.x, G = gridDim.x;
    if (tid < 64) MISC[tid] = 0u;
    __syncthreads();
    unsigned* barw = (unsigned*)(args.ws + WS_CTL) + 1024;
    XcdBarrier bar; bar.bar = barw; bar.x = 0; bar.st = nullptr;
    if (args.use_bar) bar = xcd_barrier_post(barw, MISC + 8);

    float* X = args.out + O_Y; bf16* XB = (bf16*)(args.ws + WS_XB);
    float* rss0 = (float*)(args.ws + WS_RSS0); float* rss1 = (float*)(args.ws + WS_RSS1);
    bf16* U = (bf16*)(args.ws + WS_U); bf16* V = (bf16*)(args.ws + WS_V); bf16* GT = (bf16*)(args.ws + WS_GT);

    for (int ph = args.ph_lo; ph < args.ph_hi; ++ph) {
        int type, layer;
        if (ph == 0) { type = T_PRO; layer = 0; }
        else if (ph == NPHASE - 1) { type = T_FIN; layer = 0; }
        else { const int q = ph - 1, lp = q / 10, r = q % 10;
            if (r < 6) { layer = 2 * lp; type = T_G1 + r; }
            else { layer = 2 * lp + 1; type = r == 6 ? T_PL : (r == 7 ? T_G5 : (r == 8 ? T_FX : T_G6)); } }
        const int jl = layer >> 1;
        if (type == T_PRO && (PHASE_MASK & 1)) phase_prologue(args, lds, G);
        else if (type == T_G1 && (PHASE_MASK & 2)) {
            pg8::Gemm g{XB, (const bf16*)(args.ws + WS_WIN) + (size_t)jl * NIN * DM, MT, NIN, DM}; pg8::StaticOrder S; S.init(MT, NIN, G, (int)blockIdx.x);
            EpiG1 E{U, V, rss0, (float*)(args.ws + WS_VSS)};
            pg8::gemm_phase<EpiG1, pg8::StaticOrder, true, true>(lds, g, S, E);
        }
        else if (type == T_SP && (PHASE_MASK & 4)) phase_spatial(args, lds, G, jl);
        else if ((type == T_G3 || type == T_G6) && (PHASE_MASK & 8)) {
            const bool g3 = type == T_G3;
            pg8::Gemm g{g3 ? U : GT, g3 ? (const bf16*)(args.ws + WS_WOUT) + (size_t)jl * DM * DV : (const bf16*)(args.ws + WS_WDN) + (size_t)layer * DM * DFF, MT, DM, g3 ? DV : DFF};
            pg8::StaticOrder S; S.init(MT, DM, G, (int)blockIdx.x);
            EpiRes E{X, XB, g3 ? rss1 : rss0, (!g3 && (layer & 1) == 0) ? (float*)(args.ws + WS_XH) : nullptr};
            pg8::gemm_phase<EpiRes, pg8::StaticOrder, true, true>(lds, g, S, E);
        }
        else if (type == T_G5 && (PHASE_MASK & 16)) {
            pg8::Gemm g{XB, (const bf16*)(args.ws + WS_WGV) + (size_t)layer * NGV * DM, MT, NGV, DM}; pg8::StaticOrder S; S.init(MT, NGV, G, (int)blockIdx.x);
            EpiGate E{GT, rss1, args.in[I_CW] + (size_t)layer * 3 * DFF, args.in[I_CB] + (size_t)layer * DFF, (float*)(args.ws + WS_TAIL), (float*)(args.ws + WS_HEAD),
                      args.in[I_SCONV] + (size_t)layer * 128 * 2 * DFF, args.out + O_CP + (size_t)layer * 8 * 2 * DFF, args.out + O_CS + (size_t)layer * 128 * 2 * DFF};
            pg8::gemm_phase<EpiGate, pg8::StaticOrder, true, true>(lds, g, S, E);
        }
        else if (type == T_FX && (PHASE_MASK & 32)) phase_fixup(args, G, layer);
        else if (type == T_PL && (PHASE_MASK & 64)) phase_pool(args, lds, G, layer, rss0, rss1);
        else if (PHASE_MASK & 128) phase_final(args, G);
        if (ph + 1 < args.ph_hi) xcd_barrier(bar);
    }
}

extern "C" void kernel_launch(void* const* d_in, const int* in_sizes, int n_in, void* d_out, int out_size, void* d_ws, size_t ws_size, hipStream_t stream) {
    static int grid = 0;
    if (grid == 0) {
        if (n_in != 19 || (size_t)out_size != O_END || ws_size < WS_END) { fprintf(stderr, "kernel_launch: unexpected shapes: n_in %d out %d ws %zu (need %zu); nothing launched\n", n_in, out_size, ws_size, (size_t)WS_END); grid = -1; return; }
        int dev = 0, cus = 0, per_cu = 0;
        if (hipGetDevice(&dev) != hipSuccess || hipDeviceGetAttribute(&cus, hipDeviceAttributeMultiprocessorCount, dev) != hipSuccess) { grid = -1; return; }
        if (hipFuncSetAttribute((const void*)fwd_kernel, hipFuncAttributeMaxDynamicSharedMemorySize, LDS_BYTES) != hipSuccess) { fprintf(stderr, "kernel_launch: hipFuncSetAttribute failed\n"); grid = -1; return; }
        if (hipOccupancyMaxActiveBlocksPerMultiprocessor(&per_cu, (const void*)fwd_kernel, NWAVES * 64, LDS_BYTES) != hipSuccess || per_cu < 1) { fprintf(stderr, "kernel_launch: occupancy query says %d blocks per CU\n", per_cu); (void)hipGetLastError(); grid = -1; return; }
        grid = cus;
    }
    if (grid < 0) return;
    (void)hipMemsetAsync((char*)d_ws + WS_CTL, 0, CTL_ZERO_BYTES, stream);
    Args a{};
    for (int i = 0; i < 19; ++i) a.in[i] = (const float*)d_in[i];
    a.out = (float*)d_out; a.ws = (unsigned char*)d_ws;
#if N_LAUNCH_SPLIT
    for (int ph = 0; ph < NPHASE; ++ph) { a.ph_lo = ph; a.ph_hi = ph + 1; a.use_bar = 0; hipLaunchKernelGGL(fwd_kernel, dim3(grid), dim3(NWAVES * 64), LDS_BYTES, stream, a); }
#else
    a.ph_lo = 0; a.ph_hi = NPHASE; a.use_bar = 1;
    void* kargs[] = {&a};
    hipError_t e = hipLaunchCooperativeKernel((const void*)fwd_kernel, dim3(grid), dim3(NWAVES * 64), kargs, LDS_BYTES, stream);
    if (e != hipSuccess) fprintf(stderr, "kernel_launch: cooperative launch failed: %s (grid %d)\n", hipGetErrorString(e), grid);
#endif
}
```

```cpp
#include <hip/hip_runtime.h>
#include <cstdio>
#include <cstdint>
namespace pg8 {
#define PG8_LAS __attribute__((address_space(3)))
typedef unsigned short bf16_t;
typedef short bf16x8 __attribute__((ext_vector_type(8)));
typedef float f32x4 __attribute__((ext_vector_type(4)));
typedef unsigned u32x4 __attribute__((ext_vector_type(4)));
constexpr int BM = 256, BK = 64, HALF = 128, HTB = HALF * BK * 2  , STAGE_BYTES = 8 * HTB, NXCD = 8, WGM = 8;

__host__ __device__ __forceinline__ int lds_byte(int r, int c) { const int st = (r >> 4) * 2 + (c >> 5), rr = r & 15, cc = c & 31, ob = rr * 64 + cc * 2; return st * 1024 + (ob ^ (((ob >> 9) & 1) << 5)); }
__host__ __device__ __forceinline__ void stage_rc(int b, int& R, int& C) { const int st = b / 1024, sb = b % 1024, swz = sb ^ (((sb >> 9) & 1) << 5); R = (st >> 1) * 16 + swz / 64; C = (st & 1) * 32 + (swz % 64) / 2; }
__host__ __device__ __forceinline__ int perm32(int rho) { const int n = rho >> 4, i = rho & 15; return 8 * (i >> 2) + 4 * n + (i & 3); }

struct Unit { int pm, pn; };
struct Gemm { const bf16_t* A; const bf16_t* Bt; int M, N, K; };

struct StaticOrder {
    int nM, nN, nwg, G, c;
    __host__ __device__ void init(int M, int N, int G_, int c_) { nM = M / BM; nN = N / BM; nwg = nM * nN; G = G_; c = c_; }
    __host__ __device__ bool next(int i, Unit& u) const {
        const long L = (long)i * G + c; if (L >= nwg) return false;
        int wgid = (int)L; { const int q = nwg / NXCD, r = nwg % NXCD, xcd = wgid % NXCD, off = wgid / NXCD; wgid = (xcd < r ? xcd * (q + 1) : r * (q + 1) + (xcd - r) * q) + off; }
        const int nig = WGM * nN, gid = wgid / nig, fm = gid * WGM, gsz = (nM - fm) < WGM ? (nM - fm) : WGM;
        u.pm = fm + ((wgid % nig) % gsz); u.pn = (wgid % nig) / gsz; return true;
    }
    __device__ __forceinline__ void a_ready(const Unit&) const {}
    __device__ __forceinline__ void done(const Unit&) const {}
};

template <class Epi, class Sched, bool ALIGN_EPI = false, bool SP2 = false>
__device__ __forceinline__ void gemm_phase(PG8_LAS unsigned char* lds, const Gemm g, const Sched& S, const Epi& E) {
    int tid_ = threadIdx.x; asm volatile("" : "+v"(tid_)); const int tid = tid_, wid = __builtin_amdgcn_readfirstlane(tid >> 6), lane = tid & 63, wr = wid >> 2, wc = wid & 3, fr = lane & 15, fq = lane >> 4;
    const int K = g.K, nt = K / BK;
    unsigned voffA[2], voffB[2];
#pragma unroll
    for (int i = 0; i < 2; ++i) { int R, C; stage_rc(tid * 16 + i * 8192, R, C); const int Rb = Epi::PERM ? ((R & ~31) + perm32(R & 31)) : R;
        voffA[i] = (unsigned)(R * K + C) * 2u; voffB[i] = (unsigned)(Rb * K + C) * 2u; }
    const size_t kstep = (size_t)(BK * 2);
    const size_t hstep = (size_t)HALF * K * 2;
    const size_t tstep = 2 * hstep;
    const unsigned ldsw = (unsigned)wid * 1024u;
    const int aoff = lds_byte(wr * 64 + fr, fq * 8), boff = lds_byte(wc * 32 + fr, fq * 8);
#define PG8_SA(b, h) (((b) * 2 + (h)) * HTB)
#define PG8_SB(b, h) ((4 + (b) * 2 + (h)) * HTB)
#define PG8_STAGE(bufoff, gbase, voff) do { _Pragma("unroll") for (int _i = 0; _i < 2; ++_i) \
        __builtin_amdgcn_global_load_lds((const unsigned*)((const char*)(gbase) + (voff)[_i]), (PG8_LAS unsigned*)(lds + (bufoff) + ldsw + _i * 8192), 16, 0, 0); } while (0)
#define PG8_LDA(dst, b, h) do { _Pragma("unroll") for (int m = 0; m < 4; ++m) _Pragma("unroll") for (int k = 0; k < 2; ++k) dst[m][k] = *(const PG8_LAS bf16x8*)(lds + PG8_SA(b, h) + aoff + m * 2048 + k * 1024); } while (0)
#define PG8_LDB(dst, b, h) do { _Pragma("unroll") for (int n = 0; n < 2; ++n) _Pragma("unroll") for (int k = 0; k < 2; ++k) dst[n][k] = *(const PG8_LAS bf16x8*)(lds + PG8_SB(b, h) + boff + n * 2048 + k * 1024); } while (0)
#define PG8_MMA(ai, bj, At, Bt) do { __builtin_amdgcn_s_setprio(1); _Pragma("unroll") for (int m = 0; m < 4; ++m) _Pragma("unroll") for (int n = 0; n < 2; ++n) _Pragma("unroll") for (int k = 0; k < 2; ++k) \
        acc[ai][bj][m][n] = __builtin_amdgcn_mfma_f32_16x16x32_bf16(Bt[n][k], At[m][k], acc[ai][bj][m][n], 0, 0, 0); __builtin_amdgcn_s_setprio(0); } while (0)
#define PG8_WAIT_V(n) asm volatile("s_waitcnt vmcnt(" #n ")" ::: "memory")
#define PG8_WAIT_L(n) asm volatile("s_waitcnt lgkmcnt(" #n ")" ::: "memory")
#define PG8_BAR __builtin_amdgcn_s_barrier()
#define PG8_SCHED __builtin_amdgcn_sched_barrier(0)
    Unit cur, nxt; int ui = 0;
    if (!S.next(0, cur)) return;
    f32x4 acc[2][2][4][2];
#pragma unroll
    for (int a = 0; a < 2; ++a)
#pragma unroll
        for (int b = 0; b < 2; ++b)
#pragma unroll
            for (int m = 0; m < 4; ++m)
#pragma unroll
                for (int n = 0; n < 2; ++n) acc[a][b][m][n] = (f32x4){0.f, 0.f, 0.f, 0.f};
    bf16x8 At[4][2], B0[2][2], B1[2][2];
    const char* cA = (const char*)g.A + (size_t)cur.pm * tstep; const char* cB = (const char*)g.Bt + (size_t)cur.pn * tstep;
    S.a_ready(cur);
    if constexpr (SP2) {
        PG8_STAGE(PG8_SB(0, 0), cB, voffB); PG8_STAGE(PG8_SB(0, 1), cB + hstep, voffB); PG8_STAGE(PG8_SA(0, 0), cA, voffA); PG8_STAGE(PG8_SA(0, 1), cA + hstep, voffA);
        if (wr == 1) PG8_BAR;
        PG8_WAIT_V(2); PG8_BAR;
        PG8_STAGE(PG8_SB(1, 0), cB + kstep, voffB); PG8_STAGE(PG8_SA(1, 0), cA + kstep, voffA); PG8_STAGE(PG8_SB(1, 1), cB + hstep + kstep, voffB);
        PG8_WAIT_V(6); PG8_BAR;
    } else {
        PG8_STAGE(PG8_SB(0, 0), cB, voffB); PG8_STAGE(PG8_SA(0, 0), cA, voffA); PG8_STAGE(PG8_SB(0, 1), cB + hstep, voffB); PG8_STAGE(PG8_SA(0, 1), cA + hstep, voffA);
        if (wr == 1) PG8_BAR;
        PG8_WAIT_V(4); PG8_BAR;
        PG8_STAGE(PG8_SB(1, 0), cB + kstep, voffB); PG8_STAGE(PG8_SA(1, 0), cA + kstep, voffA); PG8_STAGE(PG8_SB(1, 1), cB + hstep + kstep, voffB);
        PG8_WAIT_V(6); PG8_BAR;
    }
    for (;;) {
        const bool has_next = S.next(ui + 1, nxt);
        const char* nA = has_next ? (const char*)g.A + (size_t)nxt.pm * tstep : cA; const char* nB = has_next ? (const char*)g.Bt + (size_t)nxt.pn * tstep : cB;
        for (int t = 0; t < nt; t += 2) {
            const bool last = (t == nt - 2);
            const char* a1 = cA + (size_t)(t + 1) * kstep;
            const char* a2 = last ? nA : cA + (size_t)(t + 2) * kstep; const char* b2 = last ? nB : cB + (size_t)(t + 2) * kstep;
            const char* a3 = a2 + kstep; const char* b3 = b2 + kstep;
            if (last && has_next) S.a_ready(nxt);
            if constexpr (SP2) {
            PG8_LDB(B0, 0, 0); PG8_LDB(B1, 0, 1); PG8_SCHED; PG8_LDA(At, 0, 0); PG8_STAGE(PG8_SA(1, 1), a1 + hstep, voffA);
            PG8_WAIT_V(8); PG8_WAIT_L(0); PG8_BAR; PG8_MMA(0, 0, At, B0); PG8_MMA(0, 1, At, B1); PG8_BAR; PG8_SCHED;
            PG8_LDA(At, 0, 1); PG8_STAGE(PG8_SB(0, 0), b2, voffB); PG8_STAGE(PG8_SB(0, 1), b2 + hstep, voffB); PG8_STAGE(PG8_SA(0, 0), a2, voffA);
            PG8_WAIT_V(8); PG8_WAIT_L(0); PG8_BAR; PG8_MMA(1, 0, At, B0); PG8_MMA(1, 1, At, B1); PG8_BAR; PG8_SCHED;
            PG8_LDB(B0, 1, 0); PG8_LDB(B1, 1, 1); PG8_SCHED; PG8_LDA(At, 1, 0); PG8_STAGE(PG8_SA(0, 1), a2 + hstep, voffA);
            PG8_WAIT_V(8); PG8_WAIT_L(0); PG8_BAR; PG8_MMA(0, 0, At, B0); PG8_MMA(0, 1, At, B1); PG8_BAR; PG8_SCHED;
            PG8_LDA(At, 1, 1); PG8_STAGE(PG8_SB(1, 0), b3, voffB); PG8_STAGE(PG8_SB(1, 1), b3 + hstep, voffB); PG8_STAGE(PG8_SA(1, 0), a3, voffA);
            PG8_WAIT_V(8); PG8_WAIT_L(0); PG8_BAR; PG8_MMA(1, 0, At, B0); PG8_MMA(1, 1, At, B1); PG8_BAR; PG8_SCHED;
            } else {
            PG8_LDB(B0, 0, 0); PG8_SCHED; PG8_LDA(At, 0, 0); PG8_STAGE(PG8_SA(1, 1), a1 + hstep, voffA);
            PG8_WAIT_L(8); PG8_BAR; PG8_WAIT_L(0); PG8_MMA(0, 0, At, B0); PG8_BAR; PG8_SCHED;
            PG8_LDB(B1, 0, 1); PG8_STAGE(PG8_SB(0, 0), b2, voffB);
            PG8_BAR; PG8_WAIT_L(0); PG8_MMA(0, 1, At, B1); PG8_BAR;
            PG8_LDA(At, 0, 1); PG8_STAGE(PG8_SA(0, 0), a2, voffA);
            PG8_BAR; PG8_WAIT_L(0); PG8_MMA(1, 0, At, B0); PG8_BAR; PG8_SCHED;
            PG8_STAGE(PG8_SB(0, 1), b2 + hstep, voffB);
            PG8_WAIT_V(6); PG8_BAR; PG8_MMA(1, 1, At, B1); PG8_BAR;
            PG8_LDB(B0, 1, 0); PG8_SCHED; PG8_LDA(At, 1, 0); PG8_STAGE(PG8_SA(0, 1), a2 + hstep, voffA);
            PG8_WAIT_L(8); PG8_BAR; PG8_WAIT_L(0); PG8_MMA(0, 0, At, B0); PG8_BAR; PG8_SCHED;
            PG8_LDB(B1, 1, 1); PG8_STAGE(PG8_SB(1, 0), b3, voffB);
            PG8_BAR; PG8_WAIT_L(0); PG8_MMA(0, 1, At, B1); PG8_BAR;
            PG8_LDA(At, 1, 1); PG8_STAGE(PG8_SA(1, 0), a3, voffA);
            PG8_BAR; PG8_WAIT_L(0); PG8_MMA(1, 0, At, B0); PG8_BAR; PG8_SCHED;
            PG8_STAGE(PG8_SB(1, 1), b3 + hstep, voffB);
            PG8_WAIT_V(6); PG8_BAR; PG8_MMA(1, 1, At, B1); PG8_BAR;
            }
        }
        if constexpr (ALIGN_EPI) { if (wr == 0) PG8_BAR; }
        if constexpr (!Epi::AFTER_DRAIN) { E(acc, cur, wr, wc, fr, fq); S.done(cur); }
        if (!has_next) break;
#pragma unroll
        for (int a = 0; a < 2; ++a)
#pragma unroll
            for (int b = 0; b < 2; ++b)
#pragma unroll
                for (int m = 0; m < 4; ++m)
#pragma unroll
                    for (int n = 0; n < 2; ++n) acc[a][b][m][n] = (f32x4){0.f, 0.f, 0.f, 0.f};
        cur = nxt; cA = nA; cB = nB; ++ui;
        if constexpr (ALIGN_EPI) { if (wr == 1) PG8_BAR; }
    }
    PG8_WAIT_V(0);
    if constexpr (!ALIGN_EPI) { if (wr == 0) PG8_BAR; }
    PG8_BAR;
    if constexpr (Epi::AFTER_DRAIN) { E.fused(acc, cur, wr, wc, fr, fq, lds, wid, lane); S.done(cur); }
#undef PG8_SA
#undef PG8_SB
#undef PG8_STAGE
#undef PG8_LDA
#undef PG8_LDB
#undef PG8_MMA
#undef PG8_WAIT_V
#undef PG8_WAIT_L
#undef PG8_BAR
#undef PG8_SCHED
}
}

constexpr int DM = 1024, DV = 2048, DFF = 2816, NGV = 2 * DFF, NIN = 2 * DV;
constexpr int MP = 16384, MS = 512, MT = MP + MS;
constexpr int SEQ = 2048;
constexpr float EPS = 1e-6f;
constexpr int NWAVES = 8;
constexpr int NPHASE = 22;

constexpr size_t O_Y = 0, O_GV = 17301504, O_PP = 19398656, O_PS = 19644416, O_CP = 23576576, O_CS = 23756800, O_END = 26640384;

constexpr size_t MiB = 1u << 20;
constexpr size_t WS_CTL = 0, CTL_ZERO_BYTES = 65536;
constexpr size_t WS_RSS0 = 1 * MiB, WS_RSS1 = 3 * MiB;
constexpr size_t WS_VSS = 5 * MiB;
constexpr size_t WS_WIN = 8 * MiB, WS_WOUT = 24 * MiB, WS_WGV = 32 * MiB, WS_WDN = 76 * MiB, WS_WPL = 98 * MiB;
constexpr size_t WS_XB = 99 * MiB;
constexpr size_t WS_U = 132 * MiB, WS_V = 198 * MiB;
constexpr size_t WS_GT = WS_U;
constexpr size_t WS_TAIL = 224 * MiB, WS_HEAD = 230 * MiB;
constexpr size_t WS_XH = 244 * MiB;
constexpr size_t WS_WM = 264 * MiB;
constexpr size_t WS_END = 265 * MiB;

constexpr int LDS_BYTES = 155648;
constexpr int MISC_OFF = 155648 - 256;

#define GAS __attribute__((address_space(1)))
#define LAS __attribute__((address_space(3)))
typedef unsigned short bf16;
typedef unsigned v4u __attribute__((ext_vector_type(4)));
typedef unsigned v2u __attribute__((ext_vector_type(2)));
typedef float f32x4 __attribute__((ext_vector_type(4)));
typedef float f32x2 __attribute__((ext_vector_type(2)));
typedef short bf16x8 __attribute__((ext_vector_type(8)));
typedef __bf16 bf16x2_t __attribute__((ext_vector_type(2)));
#define LDS_WAIT() asm volatile("s_waitcnt lgkmcnt(0)" ::: "memory")
#define VM_WAIT() asm volatile("s_waitcnt vmcnt(0)" ::: "memory")

__device__ __forceinline__ unsigned pk2(float lo, float hi) { f32x2 v = {lo, hi}; bf16x2_t b = __builtin_convertvector(v, bf16x2_t); return __builtin_bit_cast(unsigned, b); }
__device__ __forceinline__ float bf_lo(unsigned w) { return __builtin_bit_cast(float, w << 16); }
__device__ __forceinline__ float bf_hi(unsigned w) { return __builtin_bit_cast(float, w & 0xffff0000u); }
__device__ __forceinline__ float wave_sum(float v) {
#pragma unroll
    for (int o = 1; o < 64; o <<= 1) v += __shfl_xor(v, o);
    return v;
}
__device__ __forceinline__ float sum4(f32x4 a) { return (a.x + a.y) + (a.z + a.w); }
__device__ __forceinline__ float dot4(f32x4 a) { return (a.x * a.x + a.y * a.y) + (a.z * a.z + a.w * a.w); }
__device__ __forceinline__ float rowscale16(const float* rss, int row) {
    const f32x4 a = *(const f32x4*)(rss + (size_t)row * 4);
    return __builtin_amdgcn_rsqf(sum4(a) * (1.0f / 1024.0f) + EPS);
}
__device__ __forceinline__ float gelu_t(float x) {
    const float e = __builtin_amdgcn_exp2f(x * (-2.3022082f + -0.1029432f * x * x));
    return x * __builtin_amdgcn_rcpf(1.0f + e);
}
__device__ __forceinline__ float silu_f(float x) {
    const float e = __builtin_amdgcn_exp2f(x * -1.4426950409f);
    return x * __builtin_amdgcn_rcpf(1.0f + e);
}
template <int CTRL> __device__ __forceinline__ float dppf(float old, float src) {
    return __builtin_bit_cast(float, __builtin_amdgcn_update_dpp(__builtin_bit_cast(int, old), __builtin_bit_cast(int, src), CTRL, 0xf, 0xf, false));
}


struct EpiG1 {
    static constexpr bool PERM = true, AFTER_DRAIN = false;
    bf16* U; bf16* V; const float* rss; float* vss;
    __device__ __forceinline__ void operator()(const f32x4 (&acc)[2][2][4][2], const pg8::Unit& u, int wr, int wc, int fr, int fq) const {
        const bool isv = u.pn >= 8;
        bf16* base = isv ? V : U;
        const int col0 = (u.pn & 7) * 256 + wc * 32 + 8 * fq;
        float rrs[2][4];
#pragma unroll
        for (int ai = 0; ai < 2; ++ai)
#pragma unroll
            for (int m = 0; m < 4; ++m) rrs[ai][m] = rowscale16(rss, u.pm * 256 + ai * 128 + wr * 64 + m * 16 + fr);
#pragma unroll
        for (int ai = 0; ai < 2; ++ai)
#pragma unroll
            for (int m = 0; m < 4; ++m) {
                const int row = u.pm * 256 + ai * 128 + wr * 64 + m * 16 + fr;
                const float rr = rrs[ai][m];
                float ss = 0.f;
                bf16* rowp = base + (size_t)row * DV + col0;
#pragma unroll
                for (int bj = 0; bj < 2; ++bj) {
                    f32x4 v0 = acc[ai][bj][m][0] * rr, v1 = acc[ai][bj][m][1] * rr;
#pragma unroll
                    for (int j = 0; j < 4; ++j) { v0[j] = gelu_t(v0[j]); v1[j] = gelu_t(v1[j]); }
                    ss += dot4(v0) + dot4(v1);
                    v4u w; w.x = pk2(v0[0], v0[1]); w.y = pk2(v0[2], v0[3]); w.z = pk2(v1[0], v1[1]); w.w = pk2(v1[2], v1[3]);
                    *(v4u*)(rowp + bj * 128) = w;
                }
                if (isv) {
                    ss += __shfl_xor(ss, 16); ss += __shfl_xor(ss, 32);
                    if (fq == 0) vss[(size_t)row * 32 + (u.pn - 8) * 4 + wc] = ss;
                }
            }
    }
};

struct EpiRes {
    static constexpr bool PERM = false, AFTER_DRAIN = false;
    float* X; bf16* XB; float* rss_out; float* xh; int dry; LAS float* red;
    __device__ __forceinline__ void operator()(const f32x4 (&acc)[2][2][4][2], const pg8::Unit& u, int wr, int wc, int fr, int fq) const {
        if (dry) return;
        const int col0 = u.pn * 256 + wc * 32 + 4 * fq;
#pragma unroll
        for (int ai = 0; ai < 2; ++ai)
#pragma unroll
            for (int m = 0; m < 4; ++m) {
                const int row = u.pm * 256 + ai * 128 + wr * 64 + m * 16 + fr;
                float* xr = X + (size_t)row * DM + col0; bf16* br = XB + (size_t)row * DM + col0;
                float ss = 0.f;
                const bool hal = xh != nullptr && (row & 255) >= 241 && u.pm < 63;
                float* hr = xh + ((size_t)(u.pm + 1) * 15 + ((row & 255) - 241)) * DM + col0;
#pragma unroll
                for (int bj = 0; bj < 2; ++bj)
#pragma unroll
                    for (int n = 0; n < 2; ++n) {
                        const int o = bj * 128 + n * 16;
                        f32x4 x = *(const f32x4*)(xr + o); x += acc[ai][bj][m][n];
                        *(f32x4*)(xr + o) = x; ss += dot4(x);
                        v2u w; w.x = pk2(x[0], x[1]); w.y = pk2(x[2], x[3]); *(v2u*)(br + o) = w;
                        if (hal) *(f32x4*)(hr + o) = x;
                    }
                ss += __shfl_xor(ss, 16); ss += __shfl_xor(ss, 32);
                if (fq == 0) red[(ai * 128 + wr * 64 + m * 16 + fr) * 4 + wc] = ss;
            }
        LDS_WAIT(); __builtin_amdgcn_s_barrier(); asm volatile("" ::: "memory");
        const int t = (wr * 4 + wc) * 64 + fq * 16 + fr;
        if (t < 256) { const f32x4 v = *(const LAS f32x4*)(red + t * 4); rss_out[(size_t)(u.pm * 256 + t) * 4 + u.pn] = sum4(v); }
    }
};

struct EpiGate {
    static constexpr bool PERM = true, AFTER_DRAIN = false;
    unsigned char* ws; float* out; const float* rss; const float* cw; const float* cb; const float* state; int layer;
    __device__ __forceinline__ void operator()(const f32x4 (&acc)[2][2][4][2], const pg8::Unit& u, int wr, int wc, int fr, int fq) const {
        bf16* GT = (bf16*)(ws + WS_GT); float* tail = (float*)(ws + WS_TAIL); float* head = (float*)(ws + WS_HEAD);
        float* out_cp = out + O_CP + (size_t)layer * 8 * 2 * DFF; float* out_cs = out + O_CS + (size_t)layer * 128 * 2 * DFF;
        const int f0 = u.pn * 128 + wc * 32 + 8 * fq;
        f32x4 w0[2], w1[2], w2[2], bb[2];
#pragma unroll
        for (int n = 0; n < 2; ++n) { w0[n] = *(const f32x4*)(cw + f0 + 4 * n); w1[n] = *(const f32x4*)(cw + DFF + f0 + 4 * n); w2[n] = *(const f32x4*)(cw + 2 * DFF + f0 + 4 * n); bb[n] = *(const f32x4*)(cb + f0 + 4 * n); }
        const bool prompt = u.pm < 64;
#pragma unroll
        for (int ai = 0; ai < 2; ++ai) {
            float rrs[4];
#pragma unroll
            for (int m = 0; m < 4; ++m) rrs[m] = rowscale16(rss, u.pm * 256 + ai * 128 + wr * 64 + m * 16 + fr);
            f32x4 prev[2];
            prev[0] = (f32x4){0.f, 0.f, 0.f, 0.f}; prev[1] = prev[0];
#pragma unroll
            for (int m = 0; m < 4; ++m) {
                const int row = u.pm * 256 + ai * 128 + wr * 64 + m * 16 + fr;
                f32x4 a[2], v[2], g[2];
#pragma unroll
                for (int n = 0; n < 2; ++n) {
                    a[n] = acc[ai][0][m][n] * rrs[m]; v[n] = acc[ai][1][m][n] * rrs[m];
                    f32x4 a1, a2;
                    if (prompt) {
#pragma unroll
                        for (int k = 0; k < 4; ++k) {
                            const float t1 = dppf<0x121>(0.f, prev[n][k]), t2 = dppf<0x122>(0.f, prev[n][k]);
                            a1[k] = dppf<0x111>(t1, a[n][k]);
                            a2[k] = dppf<0x112>(t2, a[n][k]);
                        }
                    } else {
                        const int bs = (row - MP) >> 2, t = fr & 3;
                        const float* s0p = state + ((size_t)bs * 2 + 0) * DFF + f0 + 4 * n;
                        const f32x4 s0 = *(const f32x4*)s0p, s1 = *(const f32x4*)(s0p + DFF);
#pragma unroll
                        for (int k = 0; k < 4; ++k) {
                            const float x1 = dppf<0x111>(0.f, a[n][k]), x2 = dppf<0x112>(0.f, a[n][k]);
                            a1[k] = (t == 0) ? s1[k] : x1;
                            a2[k] = (t == 0) ? s0[k] : ((t == 1) ? s1[k] : x2);
                        }
                    }
                    const f32x4 cv = bb[n] + w0[n] * a2 + w1[n] * a1 + w2[n] * a[n];
#pragma unroll
                    for (int k = 0; k < 4; ++k) g[n][k] = silu_f(cv[k]) * v[n][k];
                    prev[n] = a[n];
                }
                v4u w; w.x = pk2(g[0][0], g[0][1]); w.y = pk2(g[0][2], g[0][3]); w.z = pk2(g[1][0], g[1][1]); w.w = pk2(g[1][2], g[1][3]);
                *(v4u*)(GT + (size_t)row * DFF + f0) = w;
                if (prompt) {
                    const int G = row >> 6;
                    if (m == 0 && fr < 2) { float* hp = head + ((size_t)G * 4 + fr) * DFF + f0; *(f32x4*)hp = a[0]; *(f32x4*)(hp + 4) = a[1]; *(f32x4*)(hp + 2 * DFF) = v[0]; *(f32x4*)(hp + 2 * DFF + 4) = v[1]; }
                    if (m == 3 && fr >= 14) {
                        float* tp = tail + ((size_t)G * 2 + (fr - 14)) * DFF + f0; *(f32x4*)tp = a[0]; *(f32x4*)(tp + 4) = a[1];
                        if ((row & (SEQ - 1)) >= SEQ - 2) { float* op = out_cp + ((size_t)(row >> 11) * 2 + (fr - 14)) * DFF + f0; *(f32x4*)op = a[0]; *(f32x4*)(op + 4) = a[1]; }
                    }
                } else {
                    const int t = fr & 3;
                    if (t >= 2) { float* op = out_cs + ((size_t)((row - MP) >> 2) * 2 + (t - 2)) * DFF + f0; *(f32x4*)op = a[0]; *(f32x4*)(op + 4) = a[1]; }
                }
            }
        }
    }
};
#define XB_TMO      128
#define XB_XCNT(j)  (256  + 64 * (j))
#define XB_XSUB(j)  (1280 + 64 * (j))
#define XB_XGEN(j)  (2304 + 64 * (j))
#define XB_TOP      3328
#define XB_TOPGEN   3392
#define XCD_BAR_WORDS 3456
#define XB_SPIN_CAP (1u << 18)

__device__ __forceinline__ unsigned xb_ld(unsigned* p)              { return __hip_atomic_load(p, __ATOMIC_RELAXED, __HIP_MEMORY_SCOPE_AGENT); }
__device__ __forceinline__ unsigned xb_add(unsigned* p, unsigned v) { return __hip_atomic_fetch_add(p, v, __ATOMIC_RELAXED, __HIP_MEMORY_SCOPE_AGENT); }
__device__ __forceinline__ unsigned xb_xcc_id() { return (unsigned)__builtin_amdgcn_s_getreg((3 << 11) | 20) & 0xFu; }
#define XB_SPIN(cond, bar) do { unsigned _sp = 0; while (cond) { __builtin_amdgcn_s_sleep(1); \
    if ((++_sp & 255u) == 0u) { if (xb_ld(&(bar)[XB_TMO])) break; if (_sp > XB_SPIN_CAP) { atomicAdd(&(bar)[XB_TMO], 1u); break; } } } } while (0)

struct XcdBarrier {
    unsigned* bar; unsigned x;
    volatile LAS unsigned* st;
};

__device__ __forceinline__ XcdBarrier xcd_barrier_post(unsigned* bar, volatile LAS unsigned* st) {
    XcdBarrier b; b.bar = bar; b.x = xb_xcc_id(); b.st = st;
    if (threadIdx.x == 0) (void)xb_add(&bar[XB_XCNT(b.x)], 1u);
    return b;
}
__device__ __forceinline__ void xcd_barrier_complete(unsigned* bar, unsigned x, unsigned& nloc, unsigned& nx) {
    const unsigned G = gridDim.x * gridDim.y * gridDim.z;
    unsigned sum, cnt, mine, sp = 0u;
    for (;;) {
        sum = 0u; cnt = 0u; mine = 0u;
#pragma unroll
        for (unsigned j = 0; j < 16; ++j) { const unsigned c = xb_ld(&bar[XB_XCNT(j)]); sum += c; cnt += (c > 0u) ? 1u : 0u; mine = (j == x) ? c : mine; }
        if (sum == G) break;
        __builtin_amdgcn_s_sleep(1);
        if ((++sp & 255u) == 0u) { if (xb_ld(&bar[XB_TMO])) break; if (sp > XB_SPIN_CAP) { atomicAdd(&bar[XB_TMO], 1u); break; } }
    }
    nloc = mine > 0u ? mine : 1u; nx = cnt > 0u ? cnt : 1u;
}

__device__ __forceinline__ void xcd_barrier(const XcdBarrier& b) {
    asm volatile("s_waitcnt vmcnt(0)" ::: "memory");
    __syncthreads();
    if (threadIdx.x == 0) {
        unsigned* bar = b.bar;
        __builtin_amdgcn_s_waitcnt(0);
        unsigned nloc = b.st[0], nx = b.st[1];
        if (nloc == 0u) { xcd_barrier_complete(bar, b.x, nloc, nx); b.st[0] = nloc; b.st[1] = nx; }
        const unsigned old = xb_add(&bar[XB_XSUB(b.x)], 1u);
        const unsigned gen = old / nloc;
        if (old + 1u == (gen + 1u) * nloc) {
            __builtin_amdgcn_fence(__ATOMIC_RELEASE, "agent");
            asm volatile("s_waitcnt vmcnt(0)" ::: "memory");
            const unsigned og = xb_add(&bar[XB_TOP], 1u);
            const unsigned tg = og / nx;
            if (og + 1u == (tg + 1u) * nx) xb_add(&bar[XB_TOPGEN], 1u);
            else XB_SPIN(xb_ld(&bar[XB_TOPGEN]) == tg, bar);
            __builtin_amdgcn_fence(__ATOMIC_ACQUIRE, "agent");
            xb_add(&bar[XB_XGEN(b.x)], 1u);
            asm volatile("s_waitcnt vmcnt(0)" ::: "memory");
        } else {
            XB_SPIN(xb_ld(&bar[XB_XGEN(b.x)]) == gen, bar);
            __builtin_amdgcn_fence(__ATOMIC_ACQUIRE, "agent");
            asm volatile("s_waitcnt vmcnt(0)" ::: "memory");
        }
    }
    __syncthreads();
}

struct Args { const float* in[19]; float* out; unsigned char* ws; int ph_lo, ph_hi, use_bar, pad; };
enum { I_XP = 0, I_XS, I_SPOOL, I_SCONV, I_NMIX, I_NFFN, I_NFIN, I_WIN, I_GV, I_WS, I_BS, I_WOUT, I_WPOOL, I_SCALE, I_WGATE, I_WVAL, I_CW, I_CB, I_WDOWN };

__device__ __forceinline__ void transpose_item(const float* W, int ldw, int K, bf16* WT, int wt_row0, const float* gk, LAS float* scr, int kb, int nb, int lane) {
    const int k0 = 64 * kb, n0 = 32 * nb;
#pragma unroll 8
    for (int i = 0; i < 32; ++i) { const int kk = 2 * i + (lane >> 5); scr[kk * 33 + (lane & 31)] = W[(size_t)(k0 + kk) * ldw + n0 + (lane & 31)]; }
    LDS_WAIT(); asm volatile("" ::: "memory");
    const int c = lane & 7;
    float g[8];
#pragma unroll
    for (int t = 0; t < 8; ++t) g[t] = gk ? gk[k0 + 8 * c + t] : 1.0f;
#pragma unroll
    for (int j = 0; j < 4; ++j) { const int n = (lane >> 3) + 8 * j; const LAS float* s = scr + (8 * c) * 33 + n;
        v4u o; o.x = pk2(s[0 * 33] * g[0], s[1 * 33] * g[1]); o.y = pk2(s[2 * 33] * g[2], s[3 * 33] * g[3]); o.z = pk2(s[4 * 33] * g[4], s[5 * 33] * g[5]); o.w = pk2(s[6 * 33] * g[6], s[7 * 33] * g[7]);
        *(v4u*)(WT + (size_t)(wt_row0 + n) * K + k0 + 8 * c) = o; }
    LDS_WAIT(); asm volatile("" ::: "memory");
}

__device__ __forceinline__ void phase_prologue(const Args& A, LAS unsigned char* lds, int G) {
    int tid_ = threadIdx.x; asm volatile("" : "+v"(tid_)); const int tid = tid_, lane = tid & 63, wave = __builtin_amdgcn_readfirstlane(tid >> 6);
    LAS float* scr = (LAS float*)(lds + wave * 16384);
    const int gw = blockIdx.x * NWAVES + wave, NGW = G * NWAVES;
    bf16* WIN = (bf16*)(A.ws + WS_WIN); bf16* WOUT = (bf16*)(A.ws + WS_WOUT); bf16* WGV = (bf16*)(A.ws + WS_WGV); bf16* WDN = (bf16*)(A.ws + WS_WDN); bf16* WPL = (bf16*)(A.ws + WS_WPL);
    constexpr int N_IN = 2 * 2048, N_OUT = 2 * 1024, N_GV = 4 * 2816, N_DN = 4 * 1408, N_PL = 8 * 32, NITEMS = N_IN + N_OUT + N_GV + N_DN + N_PL;
    for (int it = gw; it < NITEMS; it += NGW) {
        int r = it;
        if (r < N_IN) { const int j = r / 2048; r %= 2048; const int kb = r / 128, nb = r % 128;
            transpose_item(A.in[I_WIN] + (size_t)j * DM * NIN, NIN, DM, WIN + (size_t)j * NIN * DM, 32 * nb, A.in[I_NMIX] + (2 * j) * DM, scr, kb, nb, lane); continue; }
        r -= N_IN;
        if (r < N_OUT) { const int j = r / 1024; r %= 1024; const int kb = r / 32, nb = r % 32;
            transpose_item(A.in[I_WOUT] + (size_t)j * DV * DM, DM, DV, WOUT + (size_t)j * DM * DV, 32 * nb, nullptr, scr, kb, nb, lane); continue; }
        r -= N_OUT;
        if (r < N_GV) { const int i = r / 2816; r %= 2816; const int isval = r / 1408; r %= 1408; const int kb = r / 88, nb = r % 88; const int f0 = 32 * nb;
            transpose_item((isval ? A.in[I_WVAL] : A.in[I_WGATE]) + (size_t)i * DM * DFF, DFF, DM, WGV + (size_t)i * NGV * DM, 256 * (f0 >> 7) + 128 * isval + (f0 & 127), A.in[I_NFFN] + i * DM, scr, kb, nb, lane); continue; }
        r -= N_GV;
        if (r < N_DN) { const int i = r / 1408; r %= 1408; const int kb = r / 32, nb = r % 32;
            transpose_item(A.in[I_WDOWN] + (size_t)i * DFF * DM, DM, DFF, WDN + (size_t)i * DM * DFF, 32 * nb, nullptr, scr, kb, nb, lane); continue; }
        r -= N_DN;
        { const int jg = r / 32; r %= 32; const int kb = r / 8, nb = r % 8;
            transpose_item(A.in[I_WPOOL] + (size_t)jg * 65536, 256, 256, WPL + (size_t)jg * 65536, 32 * nb, nullptr, scr, kb, nb, lane); }
    }
    float* X = A.out + O_Y; bf16* XB = (bf16*)(A.ws + WS_XB); float* rss0 = (float*)(A.ws + WS_RSS0);
    for (int m = gw; m < MT; m += NGW) {
        const float* src = m < MP ? A.in[I_XP] + (size_t)m * DM : A.in[I_XS] + (size_t)(m - MP) * DM;
        f32x4 v[4]; float ss[4];
#pragma unroll
        for (int j = 0; j < 4; ++j) { v[j] = *(const f32x4*)(src + 256 * j + 4 * lane); ss[j] = wave_sum(dot4(v[j])); }
#pragma unroll
        for (int j = 0; j < 4; ++j) { *(f32x4*)(X + (size_t)m * DM + 256 * j + 4 * lane) = v[j]; v2u w; w.x = pk2(v[j][0], v[j][1]); w.y = pk2(v[j][2], v[j][3]); *(v2u*)(XB + (size_t)m * DM + 256 * j + 4 * lane) = w; }
        if (lane == 0) *(f32x4*)(rss0 + (size_t)m * 4) = (f32x4){ss[0], ss[1], ss[2], ss[3]};
    }
    { const float* wsa = A.in[I_WS]; bf16* wm = (bf16*)(A.ws + WS_WM);
      for (int idx = blockIdx.x * 512 + tid; idx < 2 * 2 * 8 * 16384; idx += G * 512) { const int j = idx & 127, i = (idx >> 7) & 127, h = (idx >> 14) & 7, var = (idx >> 17) & 1, l = idx >> 18;
          const float* wh = wsa + ((size_t)l * 8 + h) * 16384; float w;
          if (var == 0) w = (j <= i) ? wh[i * 128 + j] : 0.f;
          else w = ((i >> 2) == (j >> 2) && (j & 3) <= (i & 3)) ? wh[(i & 3) * 128 + (j & 3)] : 0.f;
          wm[idx] = (bf16)(pk2(w, 0.f) & 0xffffu); } }
    { const f32x4* sp = (const f32x4*)A.in[I_SPOOL]; f32x4* op = (f32x4*)(A.out + O_PS);
      const size_t tot = (size_t)256 * 2816, stride = (size_t)G * 512;
      for (size_t i = (size_t)blockIdx.x * 512 + tid; i < tot; i += stride) { const size_t jb = i / 2816, r = i % 2816; op[jb * 3840 + r] = sp[jb * 3840 + 1024 + r]; } }
}

__device__ __forceinline__ unsigned vs_off(unsigned row, unsigned ch) { return 256u * row + 16u * (ch ^ (((row & 3u) << 2) | ((row >> 2) & 3u))); }
typedef short v4i16_t __attribute__((ext_vector_type(4)));
__device__ __forceinline__ void phase_spatial(const Args& A, LAS unsigned char* lds, int G, int jl, int dry) {
    int tid_ = threadIdx.x; asm volatile("" : "+v"(tid_)); const int tid = tid_, lane = tid & 63, wave = __builtin_amdgcn_readfirstlane(tid >> 6), fr = lane & 15, fq = lane >> 4;
    LAS unsigned char* VS = lds;
    LAS bf16* WM = (LAS bf16*)(lds + 65536);
    LAS float* RV = (LAS float*)(lds + 65536 + 34816);
    bf16* U = (bf16*)(A.ws + WS_U); const bf16* V = (const bf16*)(A.ws + WS_V); const float* vss = (const float*)(A.ws + WS_VSS);
    const bf16* wmp = (const bf16*)(A.ws + WS_WM) + (size_t)jl * 2 * 8 * 16384;
    const float* bsv = A.in[I_BS] + jl * 8 * 128; const float* gv = A.in[I_GV] + jl * DV;
    float* ogv = A.out + O_GV + (size_t)jl * MS * DV;
    const unsigned tq = (lane & 15) >> 2, tp = lane & 3;
    for (int item = blockIdx.x; item < 132 * 8; item += G) {
        const int c = item >> 3, h = item & 7, R0 = 128 * c; const bool sample = c >= 128;
        if (tid < 128) { const f32x4* p = (const f32x4*)(vss + (size_t)(R0 + tid) * 32); float s = 0.f;
#pragma unroll
            for (int q = 0; q < 8; ++q) s += sum4(p[q]);
            RV[tid] = __builtin_amdgcn_rsqf(s * (1.0f / 2048.0f) + EPS); }
#pragma unroll
        for (int it = 0; it < 8; ++it) { const int idx = tid + 512 * it, j = idx >> 5, c16 = idx & 31;
            const v4u v = *(const v4u*)(V + (size_t)(R0 + j) * DV + 256 * h + 8 * c16);
            *(LAS v4u*)(VS + (c16 >> 4) * 32768 + vs_off(j, c16 & 15)) = v; }
        __syncthreads();
        const bf16* wh = wmp + ((size_t)(sample ? 8 : 0) + h) * 16384;
#pragma unroll
        for (int it = 0; it < 4; ++it) { const int idx = tid + 512 * it, i = idx >> 4, j8 = (idx & 15) * 8;
            const v4u w = *(const v4u*)(wh + i * 128 + j8);
            const f32x4 ra = *(const LAS f32x4*)(RV + j8), rb = *(const LAS f32x4*)(RV + j8 + 4);
            v4u o; o.x = pk2(bf_lo(w.x) * ra[0], bf_hi(w.x) * ra[1]); o.y = pk2(bf_lo(w.y) * ra[2], bf_hi(w.y) * ra[3]);
            o.z = pk2(bf_lo(w.z) * rb[0], bf_hi(w.z) * rb[1]); o.w = pk2(bf_lo(w.w) * rb[2], bf_hi(w.w) * rb[3]);
            *(LAS v4u*)(WM + i * 136 + j8) = o; }
        __syncthreads();
        f32x4 acc[8][2];
#pragma unroll
        for (int rb = 0; rb < 8; ++rb) { acc[rb][0] = (f32x4){0.f, 0.f, 0.f, 0.f}; acc[rb][1] = (f32x4){0.f, 0.f, 0.f, 0.f}; }
        LAS unsigned char* vsub = VS + (wave >> 2) * 32768;
#pragma unroll
        for (int ks = 0; ks < 4; ++ks) {
            bf16x8 bfr[2];
#pragma unroll
            for (int cb = 0; cb < 2; ++cb) {
                const unsigned r0 = 32 * ks + 8 * fq + tq, ch = 4 * (wave & 3) + tp;
                const v4i16_t lo = __builtin_amdgcn_ds_read_tr16_b64_v4i16((LAS v4i16_t*)(vsub + vs_off(r0, ch) + 8 * cb));
                const v4i16_t hi = __builtin_amdgcn_ds_read_tr16_b64_v4i16((LAS v4i16_t*)(vsub + vs_off(r0 + 4, ch) + 8 * cb));
                bfr[cb] = (bf16x8){lo[0], lo[1], lo[2], lo[3], hi[0], hi[1], hi[2], hi[3]};
            }
#pragma unroll
            for (int rb = 0; rb < 8; ++rb) { const bf16x8 afr = *(const LAS bf16x8*)(WM + (16 * rb + fr) * 136 + 32 * ks + 8 * fq);
                acc[rb][0] = __builtin_amdgcn_mfma_f32_16x16x32_bf16(bfr[0], afr, acc[rb][0], 0, 0, 0);
                acc[rb][1] = __builtin_amdgcn_mfma_f32_16x16x32_bf16(bfr[1], afr, acc[rb][1], 0, 0, 0); }
        }
        const int e = 256 * h + 32 * wave + 8 * fq;
        const f32x4 g0 = *(const f32x4*)(gv + e), g1 = *(const f32x4*)(gv + e + 4);
#pragma unroll
        for (int rb = 0; rb < 8; ++rb) { const int i = 16 * rb + fr, row = R0 + i; const float bi = bsv[h * 128 + (sample ? (i & 3) : i)];
            bf16* up = U + (size_t)row * DV + e; const v4u uu = *(const v4u*)up;
            const f32x4 s0 = g0 * acc[rb][0] + bi, s1 = g1 * acc[rb][1] + bi;
            v4u w; w.x = pk2(bf_lo(uu.x) * s0[0], bf_hi(uu.x) * s0[1]); w.y = pk2(bf_lo(uu.y) * s0[2], bf_hi(uu.y) * s0[3]);
            w.z = pk2(bf_lo(uu.z) * s1[0], bf_hi(uu.z) * s1[1]); w.w = pk2(bf_lo(uu.w) * s1[2], bf_hi(uu.w) * s1[3]);
            if (!dry) *(v4u*)up = w; }
        if (sample && !dry) {
            for (int idx = tid; idx < 4096; idx += 512) { const int j = idx >> 5, e8 = (idx & 31) * 8; const int ee = 256 * h + e8;
                const v4u v = *(const v4u*)(V + (size_t)(R0 + j) * DV + ee); const float rv = RV[j];
                const f32x4 ga = *(const f32x4*)(gv + ee), gb = *(const f32x4*)(gv + ee + 4);
                float* o = ogv + (size_t)(R0 - MP + j) * DV + ee;
                *(f32x4*)o = (f32x4){bf_lo(v.x) * rv * ga[0], bf_hi(v.x) * rv * ga[1], bf_lo(v.y) * rv * ga[2], bf_hi(v.y) * rv * ga[3]};
                *(f32x4*)(o + 4) = (f32x4){bf_lo(v.z) * rv * gb[0], bf_hi(v.z) * rv * gb[1], bf_lo(v.w) * rv * gb[2], bf_hi(v.w) * rv * gb[3]}; }
        }
        __syncthreads();
    }
}

__device__ __forceinline__ void phase_fixup(const Args& A, int G, int layer) {
    const float* tail = (const float*)(A.ws + WS_TAIL); const float* head = (const float*)(A.ws + WS_HEAD); bf16* GT = (bf16*)(A.ws + WS_GT);
    const float* cw = A.in[I_CW] + (size_t)layer * 3 * DFF; const float* cb = A.in[I_CB] + (size_t)layer * DFF;
    const int tot = 256 * 2 * 704;
    for (int idx = blockIdx.x * 512 + threadIdx.x; idx < tot; idx += G * 512) {
        const int Gr = idx / 1408, rem = idx % 1408, r = rem / 704, f = 4 * (rem % 704);
        if ((Gr & 31) == 0) continue;
        const f32x4 t0 = *(const f32x4*)(tail + ((size_t)(Gr - 1) * 2 + 0) * DFF + f), t1 = *(const f32x4*)(tail + ((size_t)(Gr - 1) * 2 + 1) * DFF + f);
        const f32x4 h0 = *(const f32x4*)(head + ((size_t)Gr * 4 + 0) * DFF + f), h1 = *(const f32x4*)(head + ((size_t)Gr * 4 + 1) * DFF + f);
        const f32x4 vv = *(const f32x4*)(head + ((size_t)Gr * 4 + 2 + r) * DFF + f);
        const f32x4 w0 = *(const f32x4*)(cw + f), w1 = *(const f32x4*)(cw + DFF + f), w2 = *(const f32x4*)(cw + 2 * DFF + f), bb = *(const f32x4*)(cb + f);
        const f32x4 cv = r == 0 ? bb + w0 * t0 + w1 * t1 + w2 * h0 : bb + w0 * t1 + w1 * h0 + w2 * h1;
        v2u w; w.x = pk2(silu_f(cv[0]) * vv[0], silu_f(cv[1]) * vv[1]); w.y = pk2(silu_f(cv[2]) * vv[2], silu_f(cv[3]) * vv[3]);
        *(v2u*)(GT + (size_t)(64 * Gr + r) * DFF + f) = w;
    }
}

__device__ __forceinline__ void phase_pool(const Args& A, LAS unsigned char* lds, int G, int layer, const float* rss_in, float* rss_out, int dry) {
    int tid_ = threadIdx.x; asm volatile("" : "+v"(tid_)); const int tid = tid_, lane = tid & 63, wave = __builtin_amdgcn_readfirstlane(tid >> 6), fr = lane & 15, fq = lane >> 4;
    const int jl = layer >> 1;
    LAS bf16* P = (LAS bf16*)lds;
    LAS float* RR = (LAS float*)(lds + 143616);
    LAS float* RED = (LAS float*)(lds + 143616 + 1280);
    float* X = A.out + O_Y; bf16* XB = (bf16*)(A.ws + WS_XB); const float* XH = (const float*)(A.ws + WS_XH);
    const float* gain = A.in[I_NMIX] + (size_t)layer * DM; const float* scale = A.in[I_SCALE] + (size_t)jl * DM;
    const float* spool = A.in[I_SPOOL] + (size_t)jl * 128 * 15 * DM;
    float* opp = A.out + O_PP + (size_t)jl * 8 * 15 * DM; float* ops = A.out + O_PS + (size_t)jl * 128 * 15 * DM;
    for (int item = blockIdx.x; item < 256; item += G) {
        const int slot = item >> 2, g = item & 3, W = 2 << g, R0 = 256 * slot;
        const bool seq_start = (slot & 7) == 0, seq_end = (slot & 7) == 7;
        const bf16* wp = (const bf16*)(A.ws + WS_WPL) + ((size_t)jl * 4 + g) * 65536;
        bf16x8 bfr[2][8];
#pragma unroll
        for (int cb = 0; cb < 2; ++cb)
#pragma unroll
            for (int ks = 0; ks < 8; ++ks) bfr[cb][ks] = *(const bf16x8*)(wp + (size_t)(32 * wave + 8 * (fr >> 2) + 4 * cb + (fr & 3)) * 256 + 32 * ks + 8 * fq);
        if (tid < 279) { float v;
            if (tid < 271) { const int local = tid - 15; v = (local >= 0 || !seq_start) ? rowscale16(rss_in, R0 + local) : 0.f; }
            else v = rowscale16(rss_in, MP + 8 * slot + (tid - 271));
            RR[tid] = v; }
        __syncthreads();
        const int ch = 256 * g + 4 * lane;
        const f32x4 gain4 = *(const f32x4*)(gain + ch);
        const float invW = 1.0f / (float)W;
        {
            const int r0 = 32 * wave;
            const float* xc = X + (size_t)R0 * DM + ch; const float* xhc = XH + (size_t)slot * 15 * DM + ch;
#define HROW(local) (((local) >= 0 ? *(const f32x4*)(xc + (ptrdiff_t)(local) * DM) : (seq_start ? (f32x4){0.f, 0.f, 0.f, 0.f} : *(const f32x4*)(xhc + (ptrdiff_t)((local) + 15) * DM))) * RR[(local) + 15] * gain4)
            f32x4 s = {0.f, 0.f, 0.f, 0.f};
            for (int rr = r0 - (W - 1); rr < r0; ++rr) s += HROW(rr);
#pragma unroll 8
            for (int rr = r0; rr < r0 + 32; ++rr) {
                const f32x4 a = HROW(rr); s += a;
                const int t = (R0 + rr) & (SEQ - 1); const float inv = (t + 1 < W) ? 1.0f / (float)(t + 1) : invW;
                const f32x4 pv = s * inv - a;
                v2u w; w.x = pk2(pv[0], pv[1]); w.y = pk2(pv[2], pv[3]);
                *(LAS v2u*)(P + rr * 264 + 4 * lane) = w;
                if (seq_end && rr >= 241 && !dry) *(f32x4*)(opp + ((size_t)(slot >> 3) * 15 + (rr - 241)) * DM + ch) = a;
                const int rb = rr - W + 1;
                s -= HROW(rb);
            }
#undef HROW
        }
        {
            const int srow = wave, b = 2 * slot + (srow >> 2), t = srow & 3, grow = MP + 8 * slot + srow;
            f32x4 s = {0.f, 0.f, 0.f, 0.f}, a0 = s;
            for (int d = 0; d < W; ++d) { const int k = t - d; f32x4 v;
                if (k >= 0) v = *(const f32x4*)(X + (size_t)(grow - d) * DM + ch) * RR[271 + srow - d] * gain4;
                else v = *(const f32x4*)(spool + ((size_t)b * 15 + (15 + k)) * DM + ch);
                if (d == 0) a0 = v;
                s += v; }
            const f32x4 pv = s * invW - a0;
            v2u w; w.x = pk2(pv[0], pv[1]); w.y = pk2(pv[2], pv[3]);
            *(LAS v2u*)(P + (256 + srow) * 264 + 4 * lane) = w;
            *(LAS v2u*)(P + (264 + srow) * 264 + 4 * lane) = (v2u){0u, 0u};
            if (!dry) *(f32x4*)(ops + ((size_t)b * 15 + 11 + t) * DM + ch) = a0;
        }
        __syncthreads();
        const int ce = 256 * g + 32 * wave + 8 * fq;
        const f32x4 sc0 = *(const f32x4*)(scale + ce), sc1 = *(const f32x4*)(scale + ce + 4);
#pragma unroll 2
        for (int rb = 0; rb < 17; ++rb) {
            f32x4 acc0 = {0.f, 0.f, 0.f, 0.f}, acc1 = acc0;
#pragma unroll
            for (int ks = 0; ks < 8; ++ks) { const bf16x8 afr = *(const LAS bf16x8*)(P + (16 * rb + fr) * 264 + 32 * ks + 8 * fq);
                acc0 = __builtin_amdgcn_mfma_f32_16x16x32_bf16(bfr[0][ks], afr, acc0, 0, 0, 0);
                acc1 = __builtin_amdgcn_mfma_f32_16x16x32_bf16(bfr[1][ks], afr, acc1, 0, 0, 0); }
            const int lrow = 16 * rb + fr; const bool valid = lrow < 264;
            const int grow = lrow < 256 ? R0 + lrow : (valid ? MP + 8 * slot + (lrow - 256) : 0);
            float* xp = X + (size_t)grow * DM + ce;
            f32x4 x0 = *(const f32x4*)xp, x1 = *(const f32x4*)(xp + 4);
            x0 += acc0 * sc0; x1 += acc1 * sc1;
            float ss = dot4(x0) + dot4(x1);
            ss += __shfl_xor(ss, 16); ss += __shfl_xor(ss, 32);
            if (valid && !dry) { *(f32x4*)xp = x0; *(f32x4*)(xp + 4) = x1;
                v4u w; w.x = pk2(x0[0], x0[1]); w.y = pk2(x0[2], x0[3]); w.z = pk2(x1[0], x1[1]); w.w = pk2(x1[2], x1[3]);
                *(v4u*)(XB + (size_t)grow * DM + ce) = w; }
            if (fq == 0) RED[lrow * 8 + wave] = ss;
        }
        __syncthreads();
        if (tid < 264 && !dry) { const int grow = tid < 256 ? R0 + tid : MP + 8 * slot + (tid - 256);
            const LAS f32x4* rp = (const LAS f32x4*)(RED + tid * 8); const float s = sum4(rp[0]) + sum4(rp[1]);
            rss_out[(size_t)grow * 4 + g] = s; }
        __syncthreads();
    }
}

__device__ __forceinline__ void phase_final(const Args& A, int G) {
    int tid_ = threadIdx.x; asm volatile("" : "+v"(tid_)); const int tid = tid_, lane = tid & 63, wave = __builtin_amdgcn_readfirstlane(tid >> 6);
    float* X = A.out + O_Y; const float* gf = A.in[I_NFIN];
    for (int m = blockIdx.x * NWAVES + wave; m < MT; m += G * NWAVES) {
        f32x4 v[4]; float s = 0.f;
#pragma unroll
        for (int j = 0; j < 4; ++j) { v[j] = *(const f32x4*)(X + (size_t)m * DM + 256 * j + 4 * lane); s += dot4(v[j]); }
        const float rr = __builtin_amdgcn_rsqf(wave_sum(s) * (1.0f / 1024.0f) + EPS);
#pragma unroll
        for (int j = 0; j < 4; ++j) { const f32x4 gg = *(const f32x4*)(gf + 256 * j + 4 * lane); *(f32x4*)(X + (size_t)m * DM + 256 * j + 4 * lane) = v[j] * rr * gg; }
    }
}

enum { T_PRO = 0, T_G1, T_SP, T_G3, T_G5, T_FX, T_G6, T_PL, T_FIN };
#ifndef PHASE_MASK
#define PHASE_MASK 255
#endif
#ifndef PROBE_TYPE
#define PROBE_TYPE -1
#endif
#ifndef N_LAUNCH_SPLIT
#define N_LAUNCH_SPLIT 0
#endif

__global__ void __launch_bounds__(NWAVES * 64, 2) fwd_kernel(Args args) {
    extern __shared__ __attribute__((aligned(16))) unsigned char lds_raw[];
    LAS unsigned char* lds = (LAS unsigned char*)lds_raw;
    volatile LAS unsigned* MISC = (volatile LAS unsigned*)(lds + MISC_OFF);
    const int tid = threadIdx.x, G = gridDim.x;
    if (tid < 64) MISC[tid] = 0u;
    __syncthreads();
    unsigned* barw = (unsigned*)(args.ws + WS_CTL) + 1024;
    XcdBarrier bar; bar.bar = barw; bar.x = 0; bar.st = nullptr;
    if (args.use_bar) bar = xcd_barrier_post(barw, MISC + 8);

#pragma nounroll
    for (int ph = args.ph_lo; ph < args.ph_hi; ++ph) {
        float* X = args.out + O_Y; bf16* XB = (bf16*)(args.ws + WS_XB);
        float* rss0 = (float*)(args.ws + WS_RSS0); float* rss1 = (float*)(args.ws + WS_RSS1);
        bf16* U = (bf16*)(args.ws + WS_U); bf16* V = (bf16*)(args.ws + WS_V); bf16* GT = (bf16*)(args.ws + WS_GT);
        int type, layer;
        if (ph == 0) { type = T_PRO; layer = 0; }
        else if (ph == NPHASE - 1) { type = T_FIN; layer = 0; }
        else { const int q = ph - 1, lp = q / 10, r = q % 10;
            if (r < 6) { layer = 2 * lp; type = T_G1 + r; }
            else { layer = 2 * lp + 1; type = r == 6 ? T_PL : (r == 7 ? T_G5 : (r == 8 ? T_FX : T_G6)); } }
        const int jl = layer >> 1;
        const int nrep = (type == PROBE_TYPE) ? 2 : 1;
        for (int rep = 0; rep < nrep; ++rep) {
        const int dry = rep + 1 < nrep;
        if (type == T_PRO && (PHASE_MASK & 1)) phase_prologue(args, lds, G);
        else if (type == T_G1 && (PHASE_MASK & 2)) {
            pg8::Gemm g{XB, (const bf16*)(args.ws + WS_WIN) + (size_t)jl * NIN * DM, MT, NIN, DM}; pg8::StaticOrder S; S.init(MT, NIN, G, (int)blockIdx.x);
            EpiG1 E{U, V, rss0, (float*)(args.ws + WS_VSS)};
            pg8::gemm_phase<EpiG1, pg8::StaticOrder, true, true>(lds, g, S, E);
        }
        else if (type == T_SP && (PHASE_MASK & 4)) phase_spatial(args, lds, G, jl, dry);
        else if ((type == T_G3 || type == T_G6) && (PHASE_MASK & 8)) {
            const bool g3 = type == T_G3;
            pg8::Gemm g{g3 ? U : GT, g3 ? (const bf16*)(args.ws + WS_WOUT) + (size_t)jl * DM * DV : (const bf16*)(args.ws + WS_WDN) + (size_t)layer * DM * DFF, MT, DM, g3 ? DV : DFF};
            pg8::StaticOrder S; S.init(MT, DM, G, (int)blockIdx.x);
            EpiRes E{X, XB, g3 ? rss1 : rss0, (!g3 && (layer & 1) == 0) ? (float*)(args.ws + WS_XH) : nullptr, dry, (LAS float*)(lds + 131072)};
            pg8::gemm_phase<EpiRes, pg8::StaticOrder, true, true>(lds, g, S, E);
        }
        else if (type == T_G5 && (PHASE_MASK & 16)) {
            pg8::Gemm g{XB, (const bf16*)(args.ws + WS_WGV) + (size_t)layer * NGV * DM, MT, NGV, DM}; pg8::StaticOrder S; S.init(MT, NGV, G, (int)blockIdx.x);
            EpiGate E{args.ws, args.out, rss1, args.in[I_CW] + (size_t)layer * 3 * DFF, args.in[I_CB] + (size_t)layer * DFF, args.in[I_SCONV] + (size_t)layer * 128 * 2 * DFF, layer};
            pg8::gemm_phase<EpiGate, pg8::StaticOrder, true, true>(lds, g, S, E);
        }
        else if (type == T_FX && (PHASE_MASK & 32)) phase_fixup(args, G, layer);
        else if (type == T_PL && (PHASE_MASK & 64)) phase_pool(args, lds, G, layer, rss0, rss1, dry);
        else if (PHASE_MASK & 128) phase_final(args, G);
        }
        if (ph + 1 < args.ph_hi) { xcd_barrier(bar);
#ifdef PROBE_BAR2
            xcd_barrier(bar);
#endif
        }
    }
}

extern "C" void kernel_launch(void* const* d_in, const int* in_sizes, int n_in, void* d_out, int out_size, void* d_ws, size_t ws_size, hipStream_t stream) {
    static int grid = 0;
    if (grid == 0) {
        if (n_in != 19 || (size_t)out_size != O_END || ws_size < WS_END) { fprintf(stderr, "kernel_launch: unexpected shapes: n_in %d out %d ws %zu (need %zu); nothing launched\n", n_in, out_size, ws_size, (size_t)WS_END); grid = -1; return; }
        int dev = 0, cus = 0, per_cu = 0;
        if (hipGetDevice(&dev) != hipSuccess || hipDeviceGetAttribute(&cus, hipDeviceAttributeMultiprocessorCount, dev) != hipSuccess) { grid = -1; return; }
        if (hipFuncSetAttribute((const void*)fwd_kernel, hipFuncAttributeMaxDynamicSharedMemorySize, LDS_BYTES) != hipSuccess) { fprintf(stderr, "kernel_launch: hipFuncSetAttribute failed\n"); grid = -1; return; }
        if (hipOccupancyMaxActiveBlocksPerMultiprocessor(&per_cu, (const void*)fwd_kernel, NWAVES * 64, LDS_BYTES) != hipSuccess || per_cu < 1) { fprintf(stderr, "kernel_launch: occupancy query says %d blocks per CU\n", per_cu); (void)hipGetLastError(); grid = -1; return; }
        grid = cus;
    }
    if (grid < 0) return;
    (void)hipMemsetAsync((char*)d_ws + WS_CTL, 0, CTL_ZERO_BYTES, stream);
    Args a{};
    for (int i = 0; i < 19; ++i) a.in[i] = (const float*)d_in[i];
    a.out = (float*)d_out; a.ws = (unsigned char*)d_ws;
#if N_LAUNCH_SPLIT
    for (int ph = 0; ph < NPHASE; ++ph) { a.ph_lo = ph; a.ph_hi = ph + 1; a.use_bar = 0; hipLaunchKernelGGL(fwd_kernel, dim3(grid), dim3(NWAVES * 64), LDS_BYTES, stream, a); }
#else
    a.ph_lo = 0; a.ph_hi = NPHASE; a.use_bar = 1;
    void* kargs[] = {&a};
    hipError_t e = hipLaunchCooperativeKernel((const void*)fwd_kernel, dim3(grid), dim3(NWAVES * 64), kargs, LDS_BYTES, stream);
    if (e != hipSuccess) fprintf(stderr, "kernel_launch: cooperative launch failed: %s (grid %d)\n", hipGetErrorString(e), grid);
#endif
}
```

```cpp
#include <hip/hip_runtime.h>
#include <cstdio>
#include <cstdint>
namespace pg8 {
#define PG8_LAS __attribute__((address_space(3)))
typedef unsigned short bf16_t;
typedef short bf16x8 __attribute__((ext_vector_type(8)));
typedef float f32x4 __attribute__((ext_vector_type(4)));
typedef unsigned u32x4 __attribute__((ext_vector_type(4)));
constexpr int BM = 256, BK = 64, HALF = 128, HTB = HALF * BK * 2  , STAGE_BYTES = 8 * HTB, NXCD = 8, WGM = 8;

__host__ __device__ __forceinline__ int lds_byte(int r, int c) { const int st = (r >> 4) * 2 + (c >> 5), rr = r & 15, cc = c & 31, ob = rr * 64 + cc * 2; return st * 1024 + (ob ^ (((ob >> 9) & 1) << 5)); }
__host__ __device__ __forceinline__ void stage_rc(int b, int& R, int& C) { const int st = b / 1024, sb = b % 1024, swz = sb ^ (((sb >> 9) & 1) << 5); R = (st >> 1) * 16 + swz / 64; C = (st & 1) * 32 + (swz % 64) / 2; }
__host__ __device__ __forceinline__ int perm32(int rho) { const int n = rho >> 4, i = rho & 15; return 8 * (i >> 2) + 4 * n + (i & 3); }

struct Unit { int pm, pn; };
struct Gemm { const bf16_t* A; const bf16_t* Bt; int M, N, K; };

struct StaticOrder {
    int nM, nN, nwg, G, c;
    __host__ __device__ void init(int M, int N, int G_, int c_) { nM = M / BM; nN = N / BM; nwg = nM * nN; G = G_; c = c_; }
    __host__ __device__ bool next(int i, Unit& u) const {
        const long L = (long)i * G + c; if (L >= nwg) return false;
        int wgid = (int)L; { const int q = nwg / NXCD, r = nwg % NXCD, xcd = wgid % NXCD, off = wgid / NXCD; wgid = (xcd < r ? xcd * (q + 1) : r * (q + 1) + (xcd - r) * q) + off; }
        const int nig = WGM * nN, gid = wgid / nig, fm = gid * WGM, gsz = (nM - fm) < WGM ? (nM - fm) : WGM;
        u.pm = fm + ((wgid % nig) % gsz); u.pn = (wgid % nig) / gsz; return true;
    }
    __device__ __forceinline__ void a_ready(const Unit&) const {}
    __device__ __forceinline__ void done(const Unit&) const {}
};

template <class Epi, class Sched, bool ALIGN_EPI = false, bool SP2 = false>
__device__ __forceinline__ void gemm_phase(PG8_LAS unsigned char* lds, const Gemm g, const Sched& S, const Epi& E) {
    int tid_ = threadIdx.x; asm volatile("" : "+v"(tid_)); const int tid = tid_, wid = __builtin_amdgcn_readfirstlane(tid >> 6), lane = tid & 63, wr = wid >> 2, wc = wid & 3, fr = lane & 15, fq = lane >> 4;
    const int K = g.K, nt = K / BK;
    unsigned voffA[2], voffB[2];
#pragma unroll
    for (int i = 0; i < 2; ++i) { int R, C; stage_rc(tid * 16 + i * 8192, R, C); const int Rb = Epi::PERM ? ((R & ~31) + perm32(R & 31)) : R;
        voffA[i] = (unsigned)(R * K + C) * 2u; voffB[i] = (unsigned)(Rb * K + C) * 2u; }
    const size_t kstep = (size_t)(BK * 2);
    const size_t hstep = (size_t)HALF * K * 2;
    const size_t tstep = 2 * hstep;
    const unsigned ldsw = (unsigned)wid * 1024u;
    const int aoff = lds_byte(wr * 64 + fr, fq * 8), boff = lds_byte(wc * 32 + fr, fq * 8);
#define PG8_SA(b, h) (((b) * 2 + (h)) * HTB)
#define PG8_SB(b, h) ((4 + (b) * 2 + (h)) * HTB)
#define PG8_STAGE(bufoff, gbase, voff) do { _Pragma("unroll") for (int _i = 0; _i < 2; ++_i) \
        __builtin_amdgcn_global_load_lds((const unsigned*)((const char*)(gbase) + (voff)[_i]), (PG8_LAS unsigned*)(lds + (bufoff) + ldsw + _i * 8192), 16, 0, 0); } while (0)
#define PG8_LDA(dst, b, h) do { _Pragma("unroll") for (int m = 0; m < 4; ++m) _Pragma("unroll") for (int k = 0; k < 2; ++k) dst[m][k] = *(const PG8_LAS bf16x8*)(lds + PG8_SA(b, h) + aoff + m * 2048 + k * 1024); } while (0)
#define PG8_LDB(dst, b, h) do { _Pragma("unroll") for (int n = 0; n < 2; ++n) _Pragma("unroll") for (int k = 0; k < 2; ++k) dst[n][k] = *(const PG8_LAS bf16x8*)(lds + PG8_SB(b, h) + boff + n * 2048 + k * 1024); } while (0)
#define PG8_MMA(ai, bj, At, Bt) do { __builtin_amdgcn_s_setprio(1); _Pragma("unroll") for (int m = 0; m < 4; ++m) _Pragma("unroll") for (int n = 0; n < 2; ++n) _Pragma("unroll") for (int k = 0; k < 2; ++k) \
        acc[ai][bj][m][n] = __builtin_amdgcn_mfma_f32_16x16x32_bf16(Bt[n][k], At[m][k], acc[ai][bj][m][n], 0, 0, 0); __builtin_amdgcn_s_setprio(0); } while (0)
#define PG8_WAIT_V(n) asm volatile("s_waitcnt vmcnt(" #n ")" ::: "memory")
#define PG8_WAIT_L(n) asm volatile("s_waitcnt lgkmcnt(" #n ")" ::: "memory")
#define PG8_BAR __builtin_amdgcn_s_barrier()
#define PG8_SCHED __builtin_amdgcn_sched_barrier(0)
    Unit cur, nxt; int ui = 0;
    if (!S.next(0, cur)) return;
    f32x4 acc[2][2][4][2];
#pragma unroll
    for (int a = 0; a < 2; ++a)
#pragma unroll
        for (int b = 0; b < 2; ++b)
#pragma unroll
            for (int m = 0; m < 4; ++m)
#pragma unroll
                for (int n = 0; n < 2; ++n) acc[a][b][m][n] = (f32x4){0.f, 0.f, 0.f, 0.f};
    bf16x8 At[4][2], B0[2][2], B1[2][2];
    const char* cA = (const char*)g.A + (size_t)cur.pm * tstep; const char* cB = (const char*)g.Bt + (size_t)cur.pn * tstep;
    S.a_ready(cur);
    if constexpr (SP2) {
        PG8_STAGE(PG8_SB(0, 0), cB, voffB); PG8_STAGE(PG8_SB(0, 1), cB + hstep, voffB); PG8_STAGE(PG8_SA(0, 0), cA, voffA); PG8_STAGE(PG8_SA(0, 1), cA + hstep, voffA);
        if (wr == 1) PG8_BAR;
        PG8_WAIT_V(2); PG8_BAR;
        PG8_STAGE(PG8_SB(1, 0), cB + kstep, voffB); PG8_STAGE(PG8_SA(1, 0), cA + kstep, voffA); PG8_STAGE(PG8_SB(1, 1), cB + hstep + kstep, voffB);
        PG8_WAIT_V(6); PG8_BAR;
    } else {
        PG8_STAGE(PG8_SB(0, 0), cB, voffB); PG8_STAGE(PG8_SA(0, 0), cA, voffA); PG8_STAGE(PG8_SB(0, 1), cB + hstep, voffB); PG8_STAGE(PG8_SA(0, 1), cA + hstep, voffA);
        if (wr == 1) PG8_BAR;
        PG8_WAIT_V(4); PG8_BAR;
        PG8_STAGE(PG8_SB(1, 0), cB + kstep, voffB); PG8_STAGE(PG8_SA(1, 0), cA + kstep, voffA); PG8_STAGE(PG8_SB(1, 1), cB + hstep + kstep, voffB);
        PG8_WAIT_V(6); PG8_BAR;
    }
    for (;;) {
        const bool has_next = S.next(ui + 1, nxt);
        const char* nA = has_next ? (const char*)g.A + (size_t)nxt.pm * tstep : cA; const char* nB = has_next ? (const char*)g.Bt + (size_t)nxt.pn * tstep : cB;
        for (int t = 0; t < nt; t += 2) {
            const bool last = (t == nt - 2);
            const char* a1 = cA + (size_t)(t + 1) * kstep;
            const char* a2 = last ? nA : cA + (size_t)(t + 2) * kstep; const char* b2 = last ? nB : cB + (size_t)(t + 2) * kstep;
            const char* a3 = a2 + kstep; const char* b3 = b2 + kstep;
            if (last && has_next) S.a_ready(nxt);
            if constexpr (SP2) {
            PG8_LDB(B0, 0, 0); PG8_LDB(B1, 0, 1); PG8_SCHED; PG8_LDA(At, 0, 0); PG8_STAGE(PG8_SA(1, 1), a1 + hstep, voffA);
            PG8_WAIT_V(8); PG8_WAIT_L(0); PG8_BAR; PG8_MMA(0, 0, At, B0); PG8_MMA(0, 1, At, B1); PG8_BAR; PG8_SCHED;
            PG8_LDA(At, 0, 1); PG8_STAGE(PG8_SB(0, 0), b2, voffB); PG8_STAGE(PG8_SB(0, 1), b2 + hstep, voffB); PG8_STAGE(PG8_SA(0, 0), a2, voffA);
            PG8_WAIT_V(8); PG8_WAIT_L(0); PG8_BAR; PG8_MMA(1, 0, At, B0); PG8_MMA(1, 1, At, B1); PG8_BAR; PG8_SCHED;
            PG8_LDB(B0, 1, 0); PG8_LDB(B1, 1, 1); PG8_SCHED; PG8_LDA(At, 1, 0); PG8_STAGE(PG8_SA(0, 1), a2 + hstep, voffA);
            PG8_WAIT_V(8); PG8_WAIT_L(0); PG8_BAR; PG8_MMA(0, 0, At, B0); PG8_MMA(0, 1, At, B1); PG8_BAR; PG8_SCHED;
            PG8_LDA(At, 1, 1); PG8_STAGE(PG8_SB(1, 0), b3, voffB); PG8_STAGE(PG8_SB(1, 1), b3 + hstep, voffB); PG8_STAGE(PG8_SA(1, 0), a3, voffA);
            PG8_WAIT_V(8); PG8_WAIT_L(0); PG8_BAR; PG8_MMA(1, 0, At, B0); PG8_MMA(1, 1, At, B1); PG8_BAR; PG8_SCHED;
            } else {
            PG8_LDB(B0, 0, 0); PG8_SCHED; PG8_LDA(At, 0, 0); PG8_STAGE(PG8_SA(1, 1), a1 + hstep, voffA);
            PG8_WAIT_L(8); PG8_BAR; PG8_WAIT_L(0); PG8_MMA(0, 0, At, B0); PG8_BAR; PG8_SCHED;
            PG8_LDB(B1, 0, 1); PG8_STAGE(PG8_SB(0, 0), b2, voffB);
            PG8_BAR; PG8_WAIT_L(0); PG8_MMA(0, 1, At, B1); PG8_BAR;
            PG8_LDA(At, 0, 1); PG8_STAGE(PG8_SA(0, 0), a2, voffA);
            PG8_BAR; PG8_WAIT_L(0); PG8_MMA(1, 0, At, B0); PG8_BAR; PG8_SCHED;
            PG8_STAGE(PG8_SB(0, 1), b2 + hstep, voffB);
            PG8_WAIT_V(6); PG8_BAR; PG8_MMA(1, 1, At, B1); PG8_BAR;
            PG8_LDB(B0, 1, 0); PG8_SCHED; PG8_LDA(At, 1, 0); PG8_STAGE(PG8_SA(0, 1), a2 + hstep, voffA);
            PG8_WAIT_L(8); PG8_BAR; PG8_WAIT_L(0); PG8_MMA(0, 0, At, B0); PG8_BAR; PG8_SCHED;
            PG8_LDB(B1, 1, 1); PG8_STAGE(PG8_SB(1, 0), b3, voffB);
            PG8_BAR; PG8_WAIT_L(0); PG8_MMA(0, 1, At, B1); PG8_BAR;
            PG8_LDA(At, 1, 1); PG8_STAGE(PG8_SA(1, 0), a3, voffA);
            PG8_BAR; PG8_WAIT_L(0); PG8_MMA(1, 0, At, B0); PG8_BAR; PG8_SCHED;
            PG8_STAGE(PG8_SB(1, 1), b3 + hstep, voffB);
            PG8_WAIT_V(6); PG8_BAR; PG8_MMA(1, 1, At, B1); PG8_BAR;
            }
        }
        if constexpr (ALIGN_EPI) { if (wr == 0) PG8_BAR; }
        if constexpr (!Epi::AFTER_DRAIN) { E(acc, cur, wr, wc, fr, fq); S.done(cur); }
        if (!has_next) break;
#pragma unroll
        for (int a = 0; a < 2; ++a)
#pragma unroll
            for (int b = 0; b < 2; ++b)
#pragma unroll
                for (int m = 0; m < 4; ++m)
#pragma unroll
                    for (int n = 0; n < 2; ++n) acc[a][b][m][n] = (f32x4){0.f, 0.f, 0.f, 0.f};
        cur = nxt; cA = nA; cB = nB; ++ui;
        if constexpr (ALIGN_EPI) { if (wr == 1) PG8_BAR; }
    }
    PG8_WAIT_V(0);
    if constexpr (!ALIGN_EPI) { if (wr == 0) PG8_BAR; }
    PG8_BAR;
    if constexpr (Epi::AFTER_DRAIN) { E.fused(acc, cur, wr, wc, fr, fq, lds, wid, lane); S.done(cur); }
#undef PG8_SA
#undef PG8_SB
#undef PG8_STAGE
#undef PG8_LDA
#undef PG8_LDB
#undef PG8_MMA
#undef PG8_WAIT_V
#undef PG8_WAIT_L
#undef PG8_BAR
#undef PG8_SCHED
}
}

constexpr int DM = 1024, DV = 2048, DFF = 2816, NGV = 2 * DFF, NIN = 2 * DV;
constexpr int MP = 16384, MS = 512, MT = MP + MS;
constexpr int SEQ = 2048;
constexpr float EPS = 1e-6f;
constexpr int NWAVES = 8;
constexpr int NPHASE = 22;

constexpr size_t O_Y = 0, O_GV = 17301504, O_PP = 19398656, O_PS = 19644416, O_CP = 23576576, O_CS = 23756800, O_END = 26640384;

constexpr size_t MiB = 1u << 20;
constexpr size_t WS_CTL = 0, CTL_ZERO_BYTES = 65536;
constexpr size_t WS_RSS0 = 1 * MiB, WS_RSS1 = 3 * MiB;
constexpr size_t WS_VSS = 5 * MiB;
constexpr size_t WS_WIN = 8 * MiB, WS_WOUT = 24 * MiB, WS_WGV = 32 * MiB, WS_WDN = 76 * MiB, WS_WPL = 98 * MiB;
constexpr size_t WS_XB = 99 * MiB;
constexpr size_t WS_U = 132 * MiB, WS_V = 198 * MiB;
constexpr size_t WS_GT = WS_U;
constexpr size_t WS_TAIL = 224 * MiB, WS_HEAD = 230 * MiB;
constexpr size_t WS_XH = 244 * MiB;
constexpr size_t WS_WM = 264 * MiB;
constexpr size_t WS_END = 265 * MiB;

constexpr int LDS_BYTES = 155648;
constexpr int MISC_OFF = 155648 - 256;

#define GAS __attribute__((address_space(1)))
#define LAS __attribute__((address_space(3)))
typedef unsigned short bf16;
typedef unsigned v4u __attribute__((ext_vector_type(4)));
typedef unsigned v2u __attribute__((ext_vector_type(2)));
typedef float f32x4 __attribute__((ext_vector_type(4)));
typedef float f32x2 __attribute__((ext_vector_type(2)));
typedef short bf16x8 __attribute__((ext_vector_type(8)));
typedef __bf16 bf16x2_t __attribute__((ext_vector_type(2)));
#define LDS_WAIT() asm volatile("s_waitcnt lgkmcnt(0)" ::: "memory")
#define VM_WAIT() asm volatile("s_waitcnt vmcnt(0)" ::: "memory")

__device__ __forceinline__ unsigned pk2(float lo, float hi) { f32x2 v = {lo, hi}; bf16x2_t b = __builtin_convertvector(v, bf16x2_t); return __builtin_bit_cast(unsigned, b); }
__device__ __forceinline__ float bf_lo(unsigned w) { return __builtin_bit_cast(float, w << 16); }
__device__ __forceinline__ float bf_hi(unsigned w) { return __builtin_bit_cast(float, w & 0xffff0000u); }
__device__ __forceinline__ float wave_sum(float v) {
#pragma unroll
    for (int o = 1; o < 64; o <<= 1) v += __shfl_xor(v, o);
    return v;
}
__device__ __forceinline__ float sum4(f32x4 a) { return (a.x + a.y) + (a.z + a.w); }
__device__ __forceinline__ float dot4(f32x4 a) { return (a.x * a.x + a.y * a.y) + (a.z * a.z + a.w * a.w); }
__device__ __forceinline__ float rowscale16(const float* rss, int row) {
    const f32x4 a = *(const f32x4*)(rss + (size_t)row * 4);
    return __builtin_amdgcn_rsqf(sum4(a) * (1.0f / 1024.0f) + EPS);
}
__device__ __forceinline__ float gelu_t(float x) {
    const float e = __builtin_amdgcn_exp2f(x * (-2.3022082f + -0.1029432f * x * x));
    return x * __builtin_amdgcn_rcpf(1.0f + e);
}
__device__ __forceinline__ float silu_f(float x) {
    const float e = __builtin_amdgcn_exp2f(x * -1.4426950409f);
    return x * __builtin_amdgcn_rcpf(1.0f + e);
}
template <int CTRL> __device__ __forceinline__ float dppf(float old, float src) {
    return __builtin_bit_cast(float, __builtin_amdgcn_update_dpp(__builtin_bit_cast(int, old), __builtin_bit_cast(int, src), CTRL, 0xf, 0xf, false));
}


struct EpiG1 {
    static constexpr bool PERM = true, AFTER_DRAIN = false;
    bf16* U; bf16* V; const float* rss; float* vss;
    __device__ __forceinline__ void operator()(const f32x4 (&acc)[2][2][4][2], const pg8::Unit& u, int wr, int wc, int fr, int fq) const {
        const bool isv = u.pn >= 8;
        bf16* base = isv ? V : U;
        const int col0 = (u.pn & 7) * 256 + wc * 32 + 8 * fq;
        float rrs[2][4];
#pragma unroll
        for (int ai = 0; ai < 2; ++ai)
#pragma unroll
            for (int m = 0; m < 4; ++m) rrs[ai][m] = rowscale16(rss, u.pm * 256 + ai * 128 + wr * 64 + m * 16 + fr);
#pragma unroll
        for (int ai = 0; ai < 2; ++ai)
#pragma unroll
            for (int m = 0; m < 4; ++m) {
                const int row = u.pm * 256 + ai * 128 + wr * 64 + m * 16 + fr;
                const float rr = rrs[ai][m];
                float ss = 0.f;
                bf16* rowp = base + (size_t)row * DV + col0;
#pragma unroll
                for (int bj = 0; bj < 2; ++bj) {
                    f32x4 v0 = acc[ai][bj][m][0] * rr, v1 = acc[ai][bj][m][1] * rr;
#pragma unroll
                    for (int j = 0; j < 4; ++j) { v0[j] = gelu_t(v0[j]); v1[j] = gelu_t(v1[j]); }
                    ss += dot4(v0) + dot4(v1);
                    v4u w; w.x = pk2(v0[0], v0[1]); w.y = pk2(v0[2], v0[3]); w.z = pk2(v1[0], v1[1]); w.w = pk2(v1[2], v1[3]);
                    *(v4u*)(rowp + bj * 128) = w;
                }
                if (isv) {
                    ss += __shfl_xor(ss, 16); ss += __shfl_xor(ss, 32);
                    if (fq == 0) vss[(size_t)row * 32 + (u.pn - 8) * 4 + wc] = ss;
                }
            }
    }
};

struct EpiRes {
    static constexpr bool PERM = true, AFTER_DRAIN = false;
    bf16* XB; float* rss_out; bf16* xh; int dry; LAS float* red;
    __device__ __forceinline__ void operator()(const f32x4 (&acc)[2][2][4][2], const pg8::Unit& u, int wr, int wc, int fr, int fq) const {
        if (dry) return;
        const int col0 = u.pn * 256 + wc * 32 + 8 * fq;
#pragma unroll
        for (int ai = 0; ai < 2; ++ai)
#pragma unroll
            for (int m = 0; m < 4; ++m) {
                const int row = u.pm * 256 + ai * 128 + wr * 64 + m * 16 + fr;
                bf16* br = XB + (size_t)row * DM + col0;
                float ss = 0.f;
                const bool hal = xh != nullptr && (row & 255) >= 241 && u.pm < 63;
                bf16* hr = xh + ((size_t)(u.pm + 1) * 15 + ((row & 255) - 241)) * DM + col0;
#pragma unroll
                for (int bj = 0; bj < 2; ++bj) {
                    const v4u xo = *(const v4u*)(br + bj * 128);
                    f32x4 x0 = {bf_lo(xo.x), bf_hi(xo.x), bf_lo(xo.y), bf_hi(xo.y)}, x1 = {bf_lo(xo.z), bf_hi(xo.z), bf_lo(xo.w), bf_hi(xo.w)};
                    x0 += acc[ai][bj][m][0]; x1 += acc[ai][bj][m][1];
                    ss += dot4(x0) + dot4(x1);
                    v4u w; w.x = pk2(x0[0], x0[1]); w.y = pk2(x0[2], x0[3]); w.z = pk2(x1[0], x1[1]); w.w = pk2(x1[2], x1[3]);
                    *(v4u*)(br + bj * 128) = w;
                    if (hal) *(v4u*)(hr + bj * 128) = w;
                }
                ss += __shfl_xor(ss, 16); ss += __shfl_xor(ss, 32);
                if (fq == 0) red[(ai * 128 + wr * 64 + m * 16 + fr) * 4 + wc] = ss;
            }
        LDS_WAIT(); __builtin_amdgcn_s_barrier(); asm volatile("" ::: "memory");
        const int t = (wr * 4 + wc) * 64 + fq * 16 + fr;
        if (t < 256) { const f32x4 v = *(const LAS f32x4*)(red + t * 4); rss_out[(size_t)(u.pm * 256 + t) * 4 + u.pn] = sum4(v); }
    }
};

struct EpiGate {
    static constexpr bool PERM = true, AFTER_DRAIN = false;
    unsigned char* ws; float* out; const float* rss; const float* cw; const float* cb; const float* state; int layer;
    __device__ __forceinline__ void operator()(const f32x4 (&acc)[2][2][4][2], const pg8::Unit& u, int wr, int wc, int fr, int fq) const {
        bf16* GT = (bf16*)(ws + WS_GT); float* tail = (float*)(ws + WS_TAIL); float* head = (float*)(ws + WS_HEAD);
        float* out_cp = out + O_CP + (size_t)layer * 8 * 2 * DFF; float* out_cs = out + O_CS + (size_t)layer * 128 * 2 * DFF;
        const int f0 = u.pn * 128 + wc * 32 + 8 * fq;
        f32x4 w0[2], w1[2], w2[2], bb[2];
#pragma unroll
        for (int n = 0; n < 2; ++n) { w0[n] = *(const f32x4*)(cw + f0 + 4 * n); w1[n] = *(const f32x4*)(cw + DFF + f0 + 4 * n); w2[n] = *(const f32x4*)(cw + 2 * DFF + f0 + 4 * n); bb[n] = *(const f32x4*)(cb + f0 + 4 * n); }
        const bool prompt = u.pm < 64;
#pragma unroll
        for (int ai = 0; ai < 2; ++ai) {
            float rrs[4];
#pragma unroll
            for (int m = 0; m < 4; ++m) rrs[m] = rowscale16(rss, u.pm * 256 + ai * 128 + wr * 64 + m * 16 + fr);
            f32x4 prev[2];
            prev[0] = (f32x4){0.f, 0.f, 0.f, 0.f}; prev[1] = prev[0];
#pragma unroll
            for (int m = 0; m < 4; ++m) {
                const int row = u.pm * 256 + ai * 128 + wr * 64 + m * 16 + fr;
                f32x4 a[2], v[2], g[2];
#pragma unroll
                for (int n = 0; n < 2; ++n) {
                    a[n] = acc[ai][0][m][n] * rrs[m]; v[n] = acc[ai][1][m][n] * rrs[m];
                    f32x4 a1, a2;
                    if (prompt) {
#pragma unroll
                        for (int k = 0; k < 4; ++k) {
                            const float t1 = dppf<0x121>(0.f, prev[n][k]), t2 = dppf<0x122>(0.f, prev[n][k]);
                            a1[k] = dppf<0x111>(t1, a[n][k]);
                            a2[k] = dppf<0x112>(t2, a[n][k]);
                        }
                    } else {
                        const int bs = (row - MP) >> 2, t = fr & 3;
                        const float* s0p = state + ((size_t)bs * 2 + 0) * DFF + f0 + 4 * n;
                        const f32x4 s0 = *(const f32x4*)s0p, s1 = *(const f32x4*)(s0p + DFF);
#pragma unroll
                        for (int k = 0; k < 4; ++k) {
                            const float x1 = dppf<0x111>(0.f, a[n][k]), x2 = dppf<0x112>(0.f, a[n][k]);
                            a1[k] = (t == 0) ? s1[k] : x1;
                            a2[k] = (t == 0) ? s0[k] : ((t == 1) ? s1[k] : x2);
                        }
                    }
                    const f32x4 cv = bb[n] + w0[n] * a2 + w1[n] * a1 + w2[n] * a[n];
#pragma unroll
                    for (int k = 0; k < 4; ++k) g[n][k] = silu_f(cv[k]) * v[n][k];
                    prev[n] = a[n];
                }
                v4u w; w.x = pk2(g[0][0], g[0][1]); w.y = pk2(g[0][2], g[0][3]); w.z = pk2(g[1][0], g[1][1]); w.w = pk2(g[1][2], g[1][3]);
                *(v4u*)(GT + (size_t)row * DFF + f0) = w;
                if (prompt) {
                    const int G = row >> 6;
                    if (m == 0 && fr < 2) { float* hp = head + ((size_t)G * 4 + fr) * DFF + f0; *(f32x4*)hp = a[0]; *(f32x4*)(hp + 4) = a[1]; *(f32x4*)(hp + 2 * DFF) = v[0]; *(f32x4*)(hp + 2 * DFF + 4) = v[1]; }
                    if (m == 3 && fr >= 14) {
                        float* tp = tail + ((size_t)G * 2 + (fr - 14)) * DFF + f0; *(f32x4*)tp = a[0]; *(f32x4*)(tp + 4) = a[1];
                        if ((row & (SEQ - 1)) >= SEQ - 2) { float* op = out_cp + ((size_t)(row >> 11) * 2 + (fr - 14)) * DFF + f0; *(f32x4*)op = a[0]; *(f32x4*)(op + 4) = a[1]; }
                    }
                } else {
                    const int t = fr & 3;
                    if (t >= 2) { float* op = out_cs + ((size_t)((row - MP) >> 2) * 2 + (t - 2)) * DFF + f0; *(f32x4*)op = a[0]; *(f32x4*)(op + 4) = a[1]; }
                }
            }
        }
    }
};
#define XB_TMO      128
#define XB_XCNT(j)  (256  + 64 * (j))
#define XB_XSUB(j)  (1280 + 64 * (j))
#define XB_XGEN(j)  (2304 + 64 * (j))
#define XB_TOP      3328
#define XB_TOPGEN   3392
#define XCD_BAR_WORDS 3456
#define XB_SPIN_CAP (1u << 18)

__device__ __forceinline__ unsigned xb_ld(unsigned* p)              { return __hip_atomic_load(p, __ATOMIC_RELAXED, __HIP_MEMORY_SCOPE_AGENT); }
__device__ __forceinline__ unsigned xb_add(unsigned* p, unsigned v) { return __hip_atomic_fetch_add(p, v, __ATOMIC_RELAXED, __HIP_MEMORY_SCOPE_AGENT); }
__device__ __forceinline__ unsigned xb_xcc_id() { return (unsigned)__builtin_amdgcn_s_getreg((3 << 11) | 20) & 0xFu; }
#define XB_SPIN(cond, bar) do { unsigned _sp = 0; while (cond) { __builtin_amdgcn_s_sleep(1); \
    if ((++_sp & 255u) == 0u) { if (xb_ld(&(bar)[XB_TMO])) break; if (_sp > XB_SPIN_CAP) { atomicAdd(&(bar)[XB_TMO], 1u); break; } } } } while (0)

struct XcdBarrier {
    unsigned* bar; unsigned x;
    volatile LAS unsigned* st;
};

__device__ __forceinline__ XcdBarrier xcd_barrier_post(unsigned* bar, volatile LAS unsigned* st) {
    XcdBarrier b; b.bar = bar; b.x = xb_xcc_id(); b.st = st;
    if (threadIdx.x == 0) (void)xb_add(&bar[XB_XCNT(b.x)], 1u);
    return b;
}
__device__ __forceinline__ void xcd_barrier_complete(unsigned* bar, unsigned x, unsigned& nloc, unsigned& nx) {
    const unsigned G = gridDim.x * gridDim.y * gridDim.z;
    unsigned sum, cnt, mine, sp = 0u;
    for (;;) {
        sum = 0u; cnt = 0u; mine = 0u;
#pragma unroll
        for (unsigned j = 0; j < 16; ++j) { const unsigned c = xb_ld(&bar[XB_XCNT(j)]); sum += c; cnt += (c > 0u) ? 1u : 0u; mine = (j == x) ? c : mine; }
        if (sum == G) break;
        __builtin_amdgcn_s_sleep(1);
        if ((++sp & 255u) == 0u) { if (xb_ld(&bar[XB_TMO])) break; if (sp > XB_SPIN_CAP) { atomicAdd(&bar[XB_TMO], 1u); break; } }
    }
    nloc = mine > 0u ? mine : 1u; nx = cnt > 0u ? cnt : 1u;
}

__device__ __forceinline__ void xcd_barrier(const XcdBarrier& b) {
    asm volatile("s_waitcnt vmcnt(0)" ::: "memory");
    __syncthreads();
    if (threadIdx.x == 0) {
        unsigned* bar = b.bar;
        __builtin_amdgcn_s_waitcnt(0);
        unsigned nloc = b.st[0], nx = b.st[1];
        if (nloc == 0u) { xcd_barrier_complete(bar, b.x, nloc, nx); b.st[0] = nloc; b.st[1] = nx; }
        const unsigned old = xb_add(&bar[XB_XSUB(b.x)], 1u);
        const unsigned gen = old / nloc;
        if (old + 1u == (gen + 1u) * nloc) {
            __builtin_amdgcn_fence(__ATOMIC_RELEASE, "agent");
            asm volatile("s_waitcnt vmcnt(0)" ::: "memory");
            const unsigned og = xb_add(&bar[XB_TOP], 1u);
            const unsigned tg = og / nx;
            if (og + 1u == (tg + 1u) * nx) xb_add(&bar[XB_TOPGEN], 1u);
            else XB_SPIN(xb_ld(&bar[XB_TOPGEN]) == tg, bar);
            __builtin_amdgcn_fence(__ATOMIC_ACQUIRE, "agent");
            xb_add(&bar[XB_XGEN(b.x)], 1u);
            asm volatile("s_waitcnt vmcnt(0)" ::: "memory");
        } else {
            XB_SPIN(xb_ld(&bar[XB_XGEN(b.x)]) == gen, bar);
            __builtin_amdgcn_fence(__ATOMIC_ACQUIRE, "agent");
            asm volatile("s_waitcnt vmcnt(0)" ::: "memory");
        }
    }
    __syncthreads();
}

struct Args { const float* in[19]; float* out; unsigned char* ws; int ph_lo, ph_hi, use_bar, pad; };
enum { I_XP = 0, I_XS, I_SPOOL, I_SCONV, I_NMIX, I_NFFN, I_NFIN, I_WIN, I_GV, I_WS, I_BS, I_WOUT, I_WPOOL, I_SCALE, I_WGATE, I_WVAL, I_CW, I_CB, I_WDOWN };

__device__ __forceinline__ void transpose_item(const float* W, int ldw, int K, bf16* WT, int wt_row0, const float* gk, LAS float* scr, int kb, int nb, int lane) {
    const int k0 = 64 * kb, n0 = 32 * nb;
#pragma unroll 8
    for (int i = 0; i < 32; ++i) { const int kk = 2 * i + (lane >> 5); scr[kk * 33 + (lane & 31)] = W[(size_t)(k0 + kk) * ldw + n0 + (lane & 31)]; }
    LDS_WAIT(); asm volatile("" ::: "memory");
    const int c = lane & 7;
    float g[8];
#pragma unroll
    for (int t = 0; t < 8; ++t) g[t] = gk ? gk[k0 + 8 * c + t] : 1.0f;
#pragma unroll
    for (int j = 0; j < 4; ++j) { const int n = (lane >> 3) + 8 * j; const LAS float* s = scr + (8 * c) * 33 + n;
        v4u o; o.x = pk2(s[0 * 33] * g[0], s[1 * 33] * g[1]); o.y = pk2(s[2 * 33] * g[2], s[3 * 33] * g[3]); o.z = pk2(s[4 * 33] * g[4], s[5 * 33] * g[5]); o.w = pk2(s[6 * 33] * g[6], s[7 * 33] * g[7]);
        *(v4u*)(WT + (size_t)(wt_row0 + n) * K + k0 + 8 * c) = o; }
    LDS_WAIT(); asm volatile("" ::: "memory");
}

__device__ __forceinline__ void phase_prologue(const Args& A, LAS unsigned char* lds, int G) {
    int tid_ = threadIdx.x; asm volatile("" : "+v"(tid_)); const int tid = tid_, lane = tid & 63, wave = __builtin_amdgcn_readfirstlane(tid >> 6);
    LAS float* scr = (LAS float*)(lds + wave * 16384);
    const int gw = blockIdx.x * NWAVES + wave, NGW = G * NWAVES;
    bf16* WIN = (bf16*)(A.ws + WS_WIN); bf16* WOUT = (bf16*)(A.ws + WS_WOUT); bf16* WGV = (bf16*)(A.ws + WS_WGV); bf16* WDN = (bf16*)(A.ws + WS_WDN); bf16* WPL = (bf16*)(A.ws + WS_WPL);
    constexpr int N_IN = 2 * 2048, N_OUT = 2 * 1024, N_GV = 4 * 2816, N_DN = 4 * 1408, N_PL = 8 * 32, NITEMS = N_IN + N_OUT + N_GV + N_DN + N_PL;
    for (int it = gw; it < NITEMS; it += NGW) {
        int r = it;
        if (r < N_IN) { const int j = r / 2048; r %= 2048; const int kb = r / 128, nb = r % 128;
            transpose_item(A.in[I_WIN] + (size_t)j * DM * NIN, NIN, DM, WIN + (size_t)j * NIN * DM, 32 * nb, A.in[I_NMIX] + (2 * j) * DM, scr, kb, nb, lane); continue; }
        r -= N_IN;
        if (r < N_OUT) { const int j = r / 1024; r %= 1024; const int kb = r / 32, nb = r % 32;
            transpose_item(A.in[I_WOUT] + (size_t)j * DV * DM, DM, DV, WOUT + (size_t)j * DM * DV, 32 * nb, nullptr, scr, kb, nb, lane); continue; }
        r -= N_OUT;
        if (r < N_GV) { const int i = r / 2816; r %= 2816; const int isval = r / 1408; r %= 1408; const int kb = r / 88, nb = r % 88; const int f0 = 32 * nb;
            transpose_item((isval ? A.in[I_WVAL] : A.in[I_WGATE]) + (size_t)i * DM * DFF, DFF, DM, WGV + (size_t)i * NGV * DM, 256 * (f0 >> 7) + 128 * isval + (f0 & 127), A.in[I_NFFN] + i * DM, scr, kb, nb, lane); continue; }
        r -= N_GV;
        if (r < N_DN) { const int i = r / 1408; r %= 1408; const int kb = r / 32, nb = r % 32;
            transpose_item(A.in[I_WDOWN] + (size_t)i * DFF * DM, DM, DFF, WDN + (size_t)i * DM * DFF, 32 * nb, nullptr, scr, kb, nb, lane); continue; }
        r -= N_DN;
        { const int jg = r / 32; r %= 32; const int kb = r / 8, nb = r % 8;
            transpose_item(A.in[I_WPOOL] + (size_t)jg * 65536, 256, 256, WPL + (size_t)jg * 65536, 32 * nb, nullptr, scr, kb, nb, lane); }
    }
    bf16* XB = (bf16*)(A.ws + WS_XB); float* rss0 = (float*)(A.ws + WS_RSS0);
    for (int m = gw; m < MT; m += NGW) {
        const float* src = m < MP ? A.in[I_XP] + (size_t)m * DM : A.in[I_XS] + (size_t)(m - MP) * DM;
        f32x4 v[4]; float ss[4];
#pragma unroll
        for (int j = 0; j < 4; ++j) { v[j] = *(const f32x4*)(src + 256 * j + 4 * lane); ss[j] = wave_sum(dot4(v[j])); }
#pragma unroll
        for (int j = 0; j < 4; ++j) { v2u w; w.x = pk2(v[j][0], v[j][1]); w.y = pk2(v[j][2], v[j][3]); *(v2u*)(XB + (size_t)m * DM + 256 * j + 4 * lane) = w; }
        if (lane == 0) *(f32x4*)(rss0 + (size_t)m * 4) = (f32x4){ss[0], ss[1], ss[2], ss[3]};
    }
    { const float* wsa = A.in[I_WS]; bf16* wm = (bf16*)(A.ws + WS_WM);
      for (int idx = blockIdx.x * 512 + tid; idx < 2 * 2 * 8 * 16384; idx += G * 512) { const int j = idx & 127, i = (idx >> 7) & 127, h = (idx >> 14) & 7, var = (idx >> 17) & 1, l = idx >> 18;
          const float* wh = wsa + ((size_t)l * 8 + h) * 16384; float w;
          if (var == 0) w = (j <= i) ? wh[i * 128 + j] : 0.f;
          else w = ((i >> 2) == (j >> 2) && (j & 3) <= (i & 3)) ? wh[(i & 3) * 128 + (j & 3)] : 0.f;
          wm[idx] = (bf16)(pk2(w, 0.f) & 0xffffu); } }
    { const f32x4* sp = (const f32x4*)A.in[I_SPOOL]; f32x4* op = (f32x4*)(A.out + O_PS);
      const size_t tot = (size_t)256 * 2816, stride = (size_t)G * 512;
      for (size_t i = (size_t)blockIdx.x * 512 + tid; i < tot; i += stride) { const size_t jb = i / 2816, r = i % 2816; op[jb * 3840 + r] = sp[jb * 3840 + 1024 + r]; } }
}

__device__ __forceinline__ unsigned vs_off(unsigned row, unsigned ch) { return 256u * row + 16u * (ch ^ (((row & 3u) << 2) | ((row >> 2) & 3u))); }
typedef short v4i16_t __attribute__((ext_vector_type(4)));
__device__ __forceinline__ void phase_spatial(const Args& A, LAS unsigned char* lds, int G, int jl, int dry) {
    int tid_ = threadIdx.x; asm volatile("" : "+v"(tid_)); const int tid = tid_, lane = tid & 63, wave = __builtin_amdgcn_readfirstlane(tid >> 6), fr = lane & 15, fq = lane >> 4;
    LAS unsigned char* VS = lds;
    LAS bf16* WM = (LAS bf16*)(lds + 65536);
    LAS float* RV = (LAS float*)(lds + 65536 + 34816);
    bf16* U = (bf16*)(A.ws + WS_U); const bf16* V = (const bf16*)(A.ws + WS_V); const float* vss = (const float*)(A.ws + WS_VSS);
    const bf16* wmp = (const bf16*)(A.ws + WS_WM) + (size_t)jl * 2 * 8 * 16384;
    const float* bsv = A.in[I_BS] + jl * 8 * 128; const float* gv = A.in[I_GV] + jl * DV;
    float* ogv = A.out + O_GV + (size_t)jl * MS * DV;
    const unsigned tq = (lane & 15) >> 2, tp = lane & 3;
    for (int item = blockIdx.x; item < 132 * 8; item += G) {
        const int c = item >> 3, h = item & 7, R0 = 128 * c; const bool sample = c >= 128;
        if (tid < 128) { const f32x4* p = (const f32x4*)(vss + (size_t)(R0 + tid) * 32); float s = 0.f;
#pragma unroll
            for (int q = 0; q < 8; ++q) s += sum4(p[q]);
            RV[tid] = __builtin_amdgcn_rsqf(s * (1.0f / 2048.0f) + EPS); }
#pragma unroll
        for (int it = 0; it < 8; ++it) { const int idx = tid + 512 * it, j = idx >> 5, c16 = idx & 31;
            const v4u v = *(const v4u*)(V + (size_t)(R0 + j) * DV + 256 * h + 8 * c16);
            *(LAS v4u*)(VS + (c16 >> 4) * 32768 + vs_off(j, c16 & 15)) = v; }
        __syncthreads();
        const bf16* wh = wmp + ((size_t)(sample ? 8 : 0) + h) * 16384;
#pragma unroll
        for (int it = 0; it < 4; ++it) { const int idx = tid + 512 * it, i = idx >> 4, j8 = (idx & 15) * 8;
            const v4u w = *(const v4u*)(wh + i * 128 + j8);
            const f32x4 ra = *(const LAS f32x4*)(RV + j8), rb = *(const LAS f32x4*)(RV + j8 + 4);
            v4u o; o.x = pk2(bf_lo(w.x) * ra[0], bf_hi(w.x) * ra[1]); o.y = pk2(bf_lo(w.y) * ra[2], bf_hi(w.y) * ra[3]);
            o.z = pk2(bf_lo(w.z) * rb[0], bf_hi(w.z) * rb[1]); o.w = pk2(bf_lo(w.w) * rb[2], bf_hi(w.w) * rb[3]);
            *(LAS v4u*)(WM + i * 136 + j8) = o; }
        __syncthreads();
        f32x4 acc[8][2];
#pragma unroll
        for (int rb = 0; rb < 8; ++rb) { acc[rb][0] = (f32x4){0.f, 0.f, 0.f, 0.f}; acc[rb][1] = (f32x4){0.f, 0.f, 0.f, 0.f}; }
        LAS unsigned char* vsub = VS + (wave >> 2) * 32768;
#pragma unroll
        for (int ks = 0; ks < 4; ++ks) {
            bf16x8 bfr[2];
#pragma unroll
            for (int cb = 0; cb < 2; ++cb) {
                const unsigned r0 = 32 * ks + 8 * fq + tq, ch = 4 * (wave & 3) + tp;
                const v4i16_t lo = __builtin_amdgcn_ds_read_tr16_b64_v4i16((LAS v4i16_t*)(vsub + vs_off(r0, ch) + 8 * cb));
                const v4i16_t hi = __builtin_amdgcn_ds_read_tr16_b64_v4i16((LAS v4i16_t*)(vsub + vs_off(r0 + 4, ch) + 8 * cb));
                bfr[cb] = (bf16x8){lo[0], lo[1], lo[2], lo[3], hi[0], hi[1], hi[2], hi[3]};
            }
#pragma unroll
            for (int rb = 0; rb < 8; ++rb) { const bf16x8 afr = *(const LAS bf16x8*)(WM + (16 * rb + fr) * 136 + 32 * ks + 8 * fq);
                acc[rb][0] = __builtin_amdgcn_mfma_f32_16x16x32_bf16(bfr[0], afr, acc[rb][0], 0, 0, 0);
                acc[rb][1] = __builtin_amdgcn_mfma_f32_16x16x32_bf16(bfr[1], afr, acc[rb][1], 0, 0, 0); }
        }
        const int e = 256 * h + 32 * wave + 8 * fq;
        const f32x4 g0 = *(const f32x4*)(gv + e), g1 = *(const f32x4*)(gv + e + 4);
#pragma unroll
        for (int rb = 0; rb < 8; ++rb) { const int i = 16 * rb + fr, row = R0 + i; const float bi = bsv[h * 128 + (sample ? (i & 3) : i)];
            bf16* up = U + (size_t)row * DV + e; const v4u uu = *(const v4u*)up;
            const f32x4 s0 = g0 * acc[rb][0] + bi, s1 = g1 * acc[rb][1] + bi;
            v4u w; w.x = pk2(bf_lo(uu.x) * s0[0], bf_hi(uu.x) * s0[1]); w.y = pk2(bf_lo(uu.y) * s0[2], bf_hi(uu.y) * s0[3]);
            w.z = pk2(bf_lo(uu.z) * s1[0], bf_hi(uu.z) * s1[1]); w.w = pk2(bf_lo(uu.w) * s1[2], bf_hi(uu.w) * s1[3]);
            if (!dry) *(v4u*)up = w; }
        if (sample && !dry) {
            for (int idx = tid; idx < 4096; idx += 512) { const int j = idx >> 5, e8 = (idx & 31) * 8; const int ee = 256 * h + e8;
                const v4u v = *(const v4u*)(V + (size_t)(R0 + j) * DV + ee); const float rv = RV[j];
                const f32x4 ga = *(const f32x4*)(gv + ee), gb = *(const f32x4*)(gv + ee + 4);
                float* o = ogv + (size_t)(R0 - MP + j) * DV + ee;
                *(f32x4*)o = (f32x4){bf_lo(v.x) * rv * ga[0], bf_hi(v.x) * rv * ga[1], bf_lo(v.y) * rv * ga[2], bf_hi(v.y) * rv * ga[3]};
                *(f32x4*)(o + 4) = (f32x4){bf_lo(v.z) * rv * gb[0], bf_hi(v.z) * rv * gb[1], bf_lo(v.w) * rv * gb[2], bf_hi(v.w) * rv * gb[3]}; }
        }
        __syncthreads();
    }
}

__device__ __forceinline__ void phase_fixup(const Args& A, int G, int layer) {
    const float* tail = (const float*)(A.ws + WS_TAIL); const float* head = (const float*)(A.ws + WS_HEAD); bf16* GT = (bf16*)(A.ws + WS_GT);
    const float* cw = A.in[I_CW] + (size_t)layer * 3 * DFF; const float* cb = A.in[I_CB] + (size_t)layer * DFF;
    const int tot = 256 * 2 * 704;
    for (int idx = blockIdx.x * 512 + threadIdx.x; idx < tot; idx += G * 512) {
        const int Gr = idx / 1408, rem = idx % 1408, r = rem / 704, f = 4 * (rem % 704);
        if ((Gr & 31) == 0) continue;
        const f32x4 t0 = *(const f32x4*)(tail + ((size_t)(Gr - 1) * 2 + 0) * DFF + f), t1 = *(const f32x4*)(tail + ((size_t)(Gr - 1) * 2 + 1) * DFF + f);
        const f32x4 h0 = *(const f32x4*)(head + ((size_t)Gr * 4 + 0) * DFF + f), h1 = *(const f32x4*)(head + ((size_t)Gr * 4 + 1) * DFF + f);
        const f32x4 vv = *(const f32x4*)(head + ((size_t)Gr * 4 + 2 + r) * DFF + f);
        const f32x4 w0 = *(const f32x4*)(cw + f), w1 = *(const f32x4*)(cw + DFF + f), w2 = *(const f32x4*)(cw + 2 * DFF + f), bb = *(const f32x4*)(cb + f);
        const f32x4 cv = r == 0 ? bb + w0 * t0 + w1 * t1 + w2 * h0 : bb + w0 * t1 + w1 * h0 + w2 * h1;
        v2u w; w.x = pk2(silu_f(cv[0]) * vv[0], silu_f(cv[1]) * vv[1]); w.y = pk2(silu_f(cv[2]) * vv[2], silu_f(cv[3]) * vv[3]);
        *(v2u*)(GT + (size_t)(64 * Gr + r) * DFF + f) = w;
    }
}

__device__ __forceinline__ void phase_pool(const Args& A, LAS unsigned char* lds, int G, int layer, const float* rss_in, float* rss_out, int dry) {
    int tid_ = threadIdx.x; asm volatile("" : "+v"(tid_)); const int tid = tid_, lane = tid & 63, wave = __builtin_amdgcn_readfirstlane(tid >> 6), fr = lane & 15, fq = lane >> 4;
    const int jl = layer >> 1;
    LAS bf16* P = (LAS bf16*)lds;
    LAS float* RR = (LAS float*)(lds + 143616);
    LAS float* RED = (LAS float*)(lds + 143616 + 1280);
    bf16* XB = (bf16*)(A.ws + WS_XB); const bf16* XH = (const bf16*)(A.ws + WS_XH);
    const float* gain = A.in[I_NMIX] + (size_t)layer * DM; const float* scale = A.in[I_SCALE] + (size_t)jl * DM;
    const float* spool = A.in[I_SPOOL] + (size_t)jl * 128 * 15 * DM;
    float* opp = A.out + O_PP + (size_t)jl * 8 * 15 * DM; float* ops = A.out + O_PS + (size_t)jl * 128 * 15 * DM;
    for (int item = blockIdx.x; item < 256; item += G) {
        const int slot = item >> 2, g = item & 3, W = 2 << g, R0 = 256 * slot;
        const bool seq_start = (slot & 7) == 0, seq_end = (slot & 7) == 7;
        const bf16* wp = (const bf16*)(A.ws + WS_WPL) + ((size_t)jl * 4 + g) * 65536;
        bf16x8 bfr[2][8];
#pragma unroll
        for (int cb = 0; cb < 2; ++cb)
#pragma unroll
            for (int ks = 0; ks < 8; ++ks) bfr[cb][ks] = *(const bf16x8*)(wp + (size_t)(32 * wave + 8 * (fr >> 2) + 4 * cb + (fr & 3)) * 256 + 32 * ks + 8 * fq);
        if (tid < 279) { float v;
            if (tid < 271) { const int local = tid - 15; v = (local >= 0 || !seq_start) ? rowscale16(rss_in, R0 + local) : 0.f; }
            else v = rowscale16(rss_in, MP + 8 * slot + (tid - 271));
            RR[tid] = v; }
        __syncthreads();
        const int ch = 256 * g + 4 * lane;
        const f32x4 gain4 = *(const f32x4*)(gain + ch);
        const float invW = 1.0f / (float)W;
        {
            const int r0 = 32 * wave;
            const bf16* xc = XB + (size_t)R0 * DM + ch; const bf16* xhc = XH + (size_t)slot * 15 * DM + ch;
#define LDX4(p) ({ const v2u q_ = *(const v2u*)(p); (f32x4){bf_lo(q_.x), bf_hi(q_.x), bf_lo(q_.y), bf_hi(q_.y)}; })
#define HROW(local) (((local) >= 0 ? LDX4(xc + (ptrdiff_t)(local) * DM) : (seq_start ? (f32x4){0.f, 0.f, 0.f, 0.f} : LDX4(xhc + (ptrdiff_t)((local) + 15) * DM))) * RR[(local) + 15] * gain4)
            f32x4 s = {0.f, 0.f, 0.f, 0.f};
            for (int rr = r0 - (W - 1); rr < r0; ++rr) s += HROW(rr);
#pragma unroll 8
            for (int rr = r0; rr < r0 + 32; ++rr) {
                const f32x4 a = HROW(rr); s += a;
                const int t = (R0 + rr) & (SEQ - 1); const float inv = (t + 1 < W) ? 1.0f / (float)(t + 1) : invW;
                const f32x4 pv = s * inv - a;
                v2u w; w.x = pk2(pv[0], pv[1]); w.y = pk2(pv[2], pv[3]);
                *(LAS v2u*)(P + rr * 264 + 4 * lane) = w;
                if (seq_end && rr >= 241 && !dry) *(f32x4*)(opp + ((size_t)(slot >> 3) * 15 + (rr - 241)) * DM + ch) = a;
                const int rb = rr - W + 1;
                s -= HROW(rb);
            }
#undef HROW
        }
        {
            const int srow = wave, b = 2 * slot + (srow >> 2), t = srow & 3, grow = MP + 8 * slot + srow;
            f32x4 s = {0.f, 0.f, 0.f, 0.f}, a0 = s;
            for (int d = 0; d < W; ++d) { const int k = t - d; f32x4 v;
                if (k >= 0) v = LDX4(XB + (size_t)(grow - d) * DM + ch) * RR[271 + srow - d] * gain4;
                else v = *(const f32x4*)(spool + ((size_t)b * 15 + (15 + k)) * DM + ch);
                if (d == 0) a0 = v;
                s += v; }
            const f32x4 pv = s * invW - a0;
            v2u w; w.x = pk2(pv[0], pv[1]); w.y = pk2(pv[2], pv[3]);
            *(LAS v2u*)(P + (256 + srow) * 264 + 4 * lane) = w;
            *(LAS v2u*)(P + (264 + srow) * 264 + 4 * lane) = (v2u){0u, 0u};
            if (!dry) *(f32x4*)(ops + ((size_t)b * 15 + 11 + t) * DM + ch) = a0;
        }
        __syncthreads();
        const int ce = 256 * g + 32 * wave + 8 * fq;
        const f32x4 sc0 = *(const f32x4*)(scale + ce), sc1 = *(const f32x4*)(scale + ce + 4);
#pragma unroll 2
        for (int rb = 0; rb < 17; ++rb) {
            f32x4 acc0 = {0.f, 0.f, 0.f, 0.f}, acc1 = acc0;
#pragma unroll
            for (int ks = 0; ks < 8; ++ks) { const bf16x8 afr = *(const LAS bf16x8*)(P + (16 * rb + fr) * 264 + 32 * ks + 8 * fq);
                acc0 = __builtin_amdgcn_mfma_f32_16x16x32_bf16(bfr[0][ks], afr, acc0, 0, 0, 0);
                acc1 = __builtin_amdgcn_mfma_f32_16x16x32_bf16(bfr[1][ks], afr, acc1, 0, 0, 0); }
            const int lrow = 16 * rb + fr; const bool valid = lrow < 264;
            const int grow = lrow < 256 ? R0 + lrow : (valid ? MP + 8 * slot + (lrow - 256) : 0);
            bf16* xp = XB + (size_t)grow * DM + ce;
            const v4u xo = *(const v4u*)xp;
            f32x4 x0 = {bf_lo(xo.x), bf_hi(xo.x), bf_lo(xo.y), bf_hi(xo.y)}, x1 = {bf_lo(xo.z), bf_hi(xo.z), bf_lo(xo.w), bf_hi(xo.w)};
            x0 += acc0 * sc0; x1 += acc1 * sc1;
            float ss = dot4(x0) + dot4(x1);
            ss += __shfl_xor(ss, 16); ss += __shfl_xor(ss, 32);
            if (valid && !dry) { v4u w; w.x = pk2(x0[0], x0[1]); w.y = pk2(x0[2], x0[3]); w.z = pk2(x1[0], x1[1]); w.w = pk2(x1[2], x1[3]); *(v4u*)xp = w; }
            if (fq == 0) RED[lrow * 8 + wave] = ss;
        }
        __syncthreads();
        if (tid < 264 && !dry) { const int grow = tid < 256 ? R0 + tid : MP + 8 * slot + (tid - 256);
            const LAS f32x4* rp = (const LAS f32x4*)(RED + tid * 8); const float s = sum4(rp[0]) + sum4(rp[1]);
            rss_out[(size_t)grow * 4 + g] = s; }
        __syncthreads();
    }
}

__device__ __forceinline__ void phase_final(const Args& A, int G) {
    int tid_ = threadIdx.x; asm volatile("" : "+v"(tid_)); const int tid = tid_, lane = tid & 63, wave = __builtin_amdgcn_readfirstlane(tid >> 6);
    float* Y = A.out + O_Y; const bf16* XB = (const bf16*)(A.ws + WS_XB); const float* gf = A.in[I_NFIN];
    for (int m = blockIdx.x * NWAVES + wave; m < MT; m += G * NWAVES) {
        f32x4 v[4]; float s = 0.f;
#pragma unroll
        for (int j = 0; j < 2; ++j) { const v4u q = *(const v4u*)(XB + (size_t)m * DM + 512 * j + 8 * lane);
            v[2 * j] = (f32x4){bf_lo(q.x), bf_hi(q.x), bf_lo(q.y), bf_hi(q.y)}; v[2 * j + 1] = (f32x4){bf_lo(q.z), bf_hi(q.z), bf_lo(q.w), bf_hi(q.w)};
            s += dot4(v[2 * j]) + dot4(v[2 * j + 1]); }
        const float rr = __builtin_amdgcn_rsqf(wave_sum(s) * (1.0f / 1024.0f) + EPS);
#pragma unroll
        for (int j = 0; j < 2; ++j) { const float* gp = gf + 512 * j + 8 * lane; float* yp = Y + (size_t)m * DM + 512 * j + 8 * lane;
            *(f32x4*)yp = v[2 * j] * rr * *(const f32x4*)gp; *(f32x4*)(yp + 4) = v[2 * j + 1] * rr * *(const f32x4*)(gp + 4); }
    }
}

enum { T_PRO = 0, T_G1, T_SP, T_G3, T_G5, T_FX, T_G6, T_PL, T_FIN };
#ifndef PHASE_MASK
#define PHASE_MASK 255
#endif
#ifndef PROBE_TYPE
#define PROBE_TYPE -1
#endif
#ifndef N_LAUNCH_SPLIT
#define N_LAUNCH_SPLIT 0
#endif

__global__ void __launch_bounds__(NWAVES * 64, 2) fwd_kernel(Args args) {
    extern __shared__ __attribute__((aligned(16))) unsigned char lds_raw[];
    LAS unsigned char* lds = (LAS unsigned char*)lds_raw;
    volatile LAS unsigned* MISC = (volatile LAS unsigned*)(lds + MISC_OFF);
    const int tid = threadIdx.x, G = gridDim.x;
    if (tid < 64) MISC[tid] = 0u;
    __syncthreads();
    unsigned* barw = (unsigned*)(args.ws + WS_CTL) + 1024;
    XcdBarrier bar; bar.bar = barw; bar.x = 0; bar.st = nullptr;
    if (args.use_bar) bar = xcd_barrier_post(barw, MISC + 8);

#pragma nounroll
    for (int ph = args.ph_lo; ph < args.ph_hi; ++ph) {
        bf16* XB = (bf16*)(args.ws + WS_XB);
        float* rss0 = (float*)(args.ws + WS_RSS0); float* rss1 = (float*)(args.ws + WS_RSS1);
        bf16* U = (bf16*)(args.ws + WS_U); bf16* V = (bf16*)(args.ws + WS_V); bf16* GT = (bf16*)(args.ws + WS_GT);
        int type, layer;
        if (ph == 0) { type = T_PRO; layer = 0; }
        else if (ph == NPHASE - 1) { type = T_FIN; layer = 0; }
        else { const int q = ph - 1, lp = q / 10, r = q % 10;
            if (r < 6) { layer = 2 * lp; type = T_G1 + r; }
            else { layer = 2 * lp + 1; type = r == 6 ? T_PL : (r == 7 ? T_G5 : (r == 8 ? T_FX : T_G6)); } }
        const int jl = layer >> 1;
        const int nrep = (type == PROBE_TYPE) ? 2 : 1;
        for (int rep = 0; rep < nrep; ++rep) {
        const int dry = rep + 1 < nrep;
        if (type == T_PRO && (PHASE_MASK & 1)) phase_prologue(args, lds, G);
        else if (type == T_G1 && (PHASE_MASK & 2)) {
            pg8::Gemm g{XB, (const bf16*)(args.ws + WS_WIN) + (size_t)jl * NIN * DM, MT, NIN, DM}; pg8::StaticOrder S; S.init(MT, NIN, G, (int)blockIdx.x);
            EpiG1 E{U, V, rss0, (float*)(args.ws + WS_VSS)};
            pg8::gemm_phase<EpiG1, pg8::StaticOrder, true, true>(lds, g, S, E);
        }
        else if (type == T_SP && (PHASE_MASK & 4)) phase_spatial(args, lds, G, jl, dry);
        else if ((type == T_G3 || type == T_G6) && (PHASE_MASK & 8)) {
            const bool g3 = type == T_G3;
            pg8::Gemm g{g3 ? U : GT, g3 ? (const bf16*)(args.ws + WS_WOUT) + (size_t)jl * DM * DV : (const bf16*)(args.ws + WS_WDN) + (size_t)layer * DM * DFF, MT, DM, g3 ? DV : DFF};
            pg8::StaticOrder S; S.init(MT, DM, G, (int)blockIdx.x);
            EpiRes E{XB, g3 ? rss1 : rss0, (!g3 && (layer & 1) == 0) ? (bf16*)(args.ws + WS_XH) : nullptr, dry, (LAS float*)(lds + 131072)};
            pg8::gemm_phase<EpiRes, pg8::StaticOrder, true, true>(lds, g, S, E);
        }
        else if (type == T_G5 && (PHASE_MASK & 16)) {
            pg8::Gemm g{XB, (const bf16*)(args.ws + WS_WGV) + (size_t)layer * NGV * DM, MT, NGV, DM}; pg8::StaticOrder S; S.init(MT, NGV, G, (int)blockIdx.x);
            EpiGate E{args.ws, args.out, rss1, args.in[I_CW] + (size_t)layer * 3 * DFF, args.in[I_CB] + (size_t)layer * DFF, args.in[I_SCONV] + (size_t)layer * 128 * 2 * DFF, layer};
            pg8::gemm_phase<EpiGate, pg8::StaticOrder, true, true>(lds, g, S, E);
        }
        else if (type == T_FX && (PHASE_MASK & 32)) phase_fixup(args, G, layer);
        else if (type == T_PL && (PHASE_MASK & 64)) phase_pool(args, lds, G, layer, rss0, rss1, dry);
        else if (PHASE_MASK & 128) phase_final(args, G);
        }
        if (ph + 1 < args.ph_hi) { xcd_barrier(bar);
#ifdef PROBE_BAR2
            xcd_barrier(bar);
#endif
        }
    }
}

extern "C" void kernel_launch(void* const* d_in, const int* in_sizes, int n_in, void* d_out, int out_size, void* d_ws, size_t ws_size, hipStream_t stream) {
    static int grid = 0;
    if (grid == 0) {
        if (n_in != 19 || (size_t)out_size != O_END || ws_size < WS_END) { fprintf(stderr, "kernel_launch: unexpected shapes: n_in %d out %d ws %zu (need %zu); nothing launched\n", n_in, out_size, ws_size, (size_t)WS_END); grid = -1; return; }
        int dev = 0, cus = 0, per_cu = 0;
        if (hipGetDevice(&dev) != hipSuccess || hipDeviceGetAttribute(&cus, hipDeviceAttributeMultiprocessorCount, dev) != hipSuccess) { grid = -1; return; }
        if (hipFuncSetAttribute((const void*)fwd_kernel, hipFuncAttributeMaxDynamicSharedMemorySize, LDS_BYTES) != hipSuccess) { fprintf(stderr, "kernel_launch: hipFuncSetAttribute failed\n"); grid = -1; return; }
        if (hipOccupancyMaxActiveBlocksPerMultiprocessor(&per_cu, (const void*)fwd_kernel, NWAVES * 64, LDS_BYTES) != hipSuccess || per_cu < 1) { fprintf(stderr, "kernel_launch: occupancy query says %d blocks per CU\n", per_cu); (void)hipGetLastError(); grid = -1; return; }
        grid = cus;
    }
    if (grid < 0) return;
    (void)hipMemsetAsync((char*)d_ws + WS_CTL, 0, CTL_ZERO_BYTES, stream);
    Args a{};
    for (int i = 0; i < 19; ++i) a.in[i] = (const float*)d_in[i];
    a.out = (float*)d_out; a.ws = (unsigned char*)d_ws;
#if N_LAUNCH_SPLIT
    for (int ph = 0; ph < NPHASE; ++ph) { a.ph_lo = ph; a.ph_hi = ph + 1; a.use_bar = 0; hipLaunchKernelGGL(fwd_kernel, dim3(grid), dim3(NWAVES * 64), LDS_BYTES, stream, a); }
#else
    a.ph_lo = 0; a.ph_hi = NPHASE; a.use_bar = 1;
    void* kargs[] = {&a};
    hipError_t e = hipLaunchCooperativeKernel((const void*)fwd_kernel, dim3(grid), dim3(NWAVES * 64), kargs, LDS_BYTES, stream);
    if (e != hipSuccess) fprintf(stderr, "kernel_launch: cooperative launch failed: %s (grid %d)\n", hipGetErrorString(e), grid);
#endif
}
```

```cpp
#include <hip/hip_runtime.h>
#include <cstdio>
#include <cstdint>
namespace pg8 {
#define PG8_LAS __attribute__((address_space(3)))
typedef unsigned short bf16_t;
typedef short bf16x8 __attribute__((ext_vector_type(8)));
typedef float f32x4 __attribute__((ext_vector_type(4)));
typedef unsigned u32x4 __attribute__((ext_vector_type(4)));
constexpr int BM = 256, BK = 64, HALF = 128, HTB = HALF * BK * 2  , STAGE_BYTES = 8 * HTB, NXCD = 8, WGM = 8;

__host__ __device__ __forceinline__ int lds_byte(int r, int c) { const int st = (r >> 4) * 2 + (c >> 5), rr = r & 15, cc = c & 31, ob = rr * 64 + cc * 2; return st * 1024 + (ob ^ (((ob >> 9) & 1) << 5)); }
__host__ __device__ __forceinline__ void stage_rc(int b, int& R, int& C) { const int st = b / 1024, sb = b % 1024, swz = sb ^ (((sb >> 9) & 1) << 5); R = (st >> 1) * 16 + swz / 64; C = (st & 1) * 32 + (swz % 64) / 2; }
__host__ __device__ __forceinline__ int perm32(int rho) { const int n = rho >> 4, i = rho & 15; return 8 * (i >> 2) + 4 * n + (i & 3); }

struct Unit { int pm, pn; };
struct Gemm { const bf16_t* A; const bf16_t* Bt; int M, N, K; };

struct StaticOrder {
    int nM, nN, nwg, G, c;
    __host__ __device__ void init(int M, int N, int G_, int c_) { nM = M / BM; nN = N / BM; nwg = nM * nN; G = G_; c = c_; }
    __host__ __device__ bool next(int i, Unit& u) const {
        const long L = (long)i * G + c; if (L >= nwg) return false;
        int wgid = (int)L; { const int q = nwg / NXCD, r = nwg % NXCD, xcd = wgid % NXCD, off = wgid / NXCD; wgid = (xcd < r ? xcd * (q + 1) : r * (q + 1) + (xcd - r) * q) + off; }
        const int nig = WGM * nN, gid = wgid / nig, fm = gid * WGM, gsz = (nM - fm) < WGM ? (nM - fm) : WGM;
        u.pm = fm + ((wgid % nig) % gsz); u.pn = (wgid % nig) / gsz; return true;
    }
    __device__ __forceinline__ void a_ready(const Unit&) const {}
    __device__ __forceinline__ void done(const Unit&) const {}
};

template <class Epi, class Sched, bool ALIGN_EPI = false, bool SP2 = false>
__device__ __forceinline__ void gemm_phase(PG8_LAS unsigned char* lds, const Gemm g, const Sched& S, const Epi& E) {
    int tid_ = threadIdx.x; asm volatile("" : "+v"(tid_)); const int tid = tid_, wid = __builtin_amdgcn_readfirstlane(tid >> 6), lane = tid & 63, wr = wid >> 2, wc = wid & 3, fr = lane & 15, fq = lane >> 4;
    const int K = g.K, nt = K / BK;
    unsigned voffA[2], voffB[2];
#pragma unroll
    for (int i = 0; i < 2; ++i) { int R, C; stage_rc(tid * 16 + i * 8192, R, C); const int Rb = Epi::PERM ? ((R & ~31) + perm32(R & 31)) : R;
        voffA[i] = (unsigned)(R * K + C) * 2u; voffB[i] = (unsigned)(Rb * K + C) * 2u; }
    const size_t kstep = (size_t)(BK * 2);
    const size_t hstep = (size_t)HALF * K * 2;
    const size_t tstep = 2 * hstep;
    const unsigned ldsw = (unsigned)wid * 1024u;
    const int aoff = lds_byte(wr * 64 + fr, fq * 8), boff = lds_byte(wc * 32 + fr, fq * 8);
#define PG8_SA(b, h) (((b) * 2 + (h)) * HTB)
#define PG8_SB(b, h) ((4 + (b) * 2 + (h)) * HTB)
#define PG8_STAGE(bufoff, gbase, voff) do { _Pragma("unroll") for (int _i = 0; _i < 2; ++_i) \
        __builtin_amdgcn_global_load_lds((const unsigned*)((const char*)(gbase) + (voff)[_i]), (PG8_LAS unsigned*)(lds + (bufoff) + ldsw + _i * 8192), 16, 0, 0); } while (0)
#define PG8_LDA(dst, b, h) do { _Pragma("unroll") for (int m = 0; m < 4; ++m) _Pragma("unroll") for (int k = 0; k < 2; ++k) dst[m][k] = *(const PG8_LAS bf16x8*)(lds + PG8_SA(b, h) + aoff + m * 2048 + k * 1024); } while (0)
#define PG8_LDB(dst, b, h) do { _Pragma("unroll") for (int n = 0; n < 2; ++n) _Pragma("unroll") for (int k = 0; k < 2; ++k) dst[n][k] = *(const PG8_LAS bf16x8*)(lds + PG8_SB(b, h) + boff + n * 2048 + k * 1024); } while (0)
#define PG8_MMA(ai, bj, At, Bt) do { __builtin_amdgcn_s_setprio(1); _Pragma("unroll") for (int m = 0; m < 4; ++m) _Pragma("unroll") for (int n = 0; n < 2; ++n) _Pragma("unroll") for (int k = 0; k < 2; ++k) \
        acc[ai][bj][m][n] = __builtin_amdgcn_mfma_f32_16x16x32_bf16(Bt[n][k], At[m][k], acc[ai][bj][m][n], 0, 0, 0); __builtin_amdgcn_s_setprio(0); } while (0)
#define PG8_WAIT_V(n) asm volatile("s_waitcnt vmcnt(" #n ")" ::: "memory")
#define PG8_WAIT_L(n) asm volatile("s_waitcnt lgkmcnt(" #n ")" ::: "memory")
#define PG8_BAR __builtin_amdgcn_s_barrier()
#define PG8_SCHED __builtin_amdgcn_sched_barrier(0)
    Unit cur, nxt; int ui = 0;
    if (!S.next(0, cur)) return;
    f32x4 acc[2][2][4][2];
#pragma unroll
    for (int a = 0; a < 2; ++a)
#pragma unroll
        for (int b = 0; b < 2; ++b)
#pragma unroll
            for (int m = 0; m < 4; ++m)
#pragma unroll
                for (int n = 0; n < 2; ++n) acc[a][b][m][n] = (f32x4){0.f, 0.f, 0.f, 0.f};
    bf16x8 At[4][2], B0[2][2], B1[2][2];
    const char* cA = (const char*)g.A + (size_t)cur.pm * tstep; const char* cB = (const char*)g.Bt + (size_t)cur.pn * tstep;
    S.a_ready(cur);
    if constexpr (SP2) {
        PG8_STAGE(PG8_SB(0, 0), cB, voffB); PG8_STAGE(PG8_SB(0, 1), cB + hstep, voffB); PG8_STAGE(PG8_SA(0, 0), cA, voffA); PG8_STAGE(PG8_SA(0, 1), cA + hstep, voffA);
        if (wr == 1) PG8_BAR;
        PG8_WAIT_V(2); PG8_BAR;
        PG8_STAGE(PG8_SB(1, 0), cB + kstep, voffB); PG8_STAGE(PG8_SA(1, 0), cA + kstep, voffA); PG8_STAGE(PG8_SB(1, 1), cB + hstep + kstep, voffB);
        PG8_WAIT_V(6); PG8_BAR;
    } else {
        PG8_STAGE(PG8_SB(0, 0), cB, voffB); PG8_STAGE(PG8_SA(0, 0), cA, voffA); PG8_STAGE(PG8_SB(0, 1), cB + hstep, voffB); PG8_STAGE(PG8_SA(0, 1), cA + hstep, voffA);
        if (wr == 1) PG8_BAR;
        PG8_WAIT_V(4); PG8_BAR;
        PG8_STAGE(PG8_SB(1, 0), cB + kstep, voffB); PG8_STAGE(PG8_SA(1, 0), cA + kstep, voffA); PG8_STAGE(PG8_SB(1, 1), cB + hstep + kstep, voffB);
        PG8_WAIT_V(6); PG8_BAR;
    }
    for (;;) {
        const bool has_next = S.next(ui + 1, nxt);
        const char* nA = has_next ? (const char*)g.A + (size_t)nxt.pm * tstep : cA; const char* nB = has_next ? (const char*)g.Bt + (size_t)nxt.pn * tstep : cB;
        for (int t = 0; t < nt; t += 2) {
            const bool last = (t == nt - 2);
            const char* a1 = cA + (size_t)(t + 1) * kstep;
            const char* a2 = last ? nA : cA + (size_t)(t + 2) * kstep; const char* b2 = last ? nB : cB + (size_t)(t + 2) * kstep;
            const char* a3 = a2 + kstep; const char* b3 = b2 + kstep;
            if (last && has_next) S.a_ready(nxt);
            if constexpr (SP2) {
            PG8_LDB(B0, 0, 0); PG8_LDB(B1, 0, 1); PG8_SCHED; PG8_LDA(At, 0, 0); PG8_STAGE(PG8_SA(1, 1), a1 + hstep, voffA);
            PG8_WAIT_V(8); PG8_WAIT_L(0); PG8_BAR; PG8_MMA(0, 0, At, B0); PG8_MMA(0, 1, At, B1); PG8_BAR; PG8_SCHED;
            PG8_LDA(At, 0, 1); PG8_STAGE(PG8_SB(0, 0), b2, voffB); PG8_STAGE(PG8_SB(0, 1), b2 + hstep, voffB); PG8_STAGE(PG8_SA(0, 0), a2, voffA);
            PG8_WAIT_V(8); PG8_WAIT_L(0); PG8_BAR; PG8_MMA(1, 0, At, B0); PG8_MMA(1, 1, At, B1); PG8_BAR; PG8_SCHED;
            PG8_LDB(B0, 1, 0); PG8_LDB(B1, 1, 1); PG8_SCHED; PG8_LDA(At, 1, 0); PG8_STAGE(PG8_SA(0, 1), a2 + hstep, voffA);
            PG8_WAIT_V(8); PG8_WAIT_L(0); PG8_BAR; PG8_MMA(0, 0, At, B0); PG8_MMA(0, 1, At, B1); PG8_BAR; PG8_SCHED;
            PG8_LDA(At, 1, 1); PG8_STAGE(PG8_SB(1, 0), b3, voffB); PG8_STAGE(PG8_SB(1, 1), b3 + hstep, voffB); PG8_STAGE(PG8_SA(1, 0), a3, voffA);
            PG8_WAIT_V(8); PG8_WAIT_L(0); PG8_BAR; PG8_MMA(1, 0, At, B0); PG8_MMA(1, 1, At, B1); PG8_BAR; PG8_SCHED;
            } else {
            PG8_LDB(B0, 0, 0); PG8_SCHED; PG8_LDA(At, 0, 0); PG8_STAGE(PG8_SA(1, 1), a1 + hstep, voffA);
            PG8_WAIT_L(8); PG8_BAR; PG8_WAIT_L(0); PG8_MMA(0, 0, At, B0); PG8_BAR; PG8_SCHED;
            PG8_LDB(B1, 0, 1); PG8_STAGE(PG8_SB(0, 0), b2, voffB);
            PG8_BAR; PG8_WAIT_L(0); PG8_MMA(0, 1, At, B1); PG8_BAR;
            PG8_LDA(At, 0, 1); PG8_STAGE(PG8_SA(0, 0), a2, voffA);
            PG8_BAR; PG8_WAIT_L(0); PG8_MMA(1, 0, At, B0); PG8_BAR; PG8_SCHED;
            PG8_STAGE(PG8_SB(0, 1), b2 + hstep, voffB);
            PG8_WAIT_V(6); PG8_BAR; PG8_MMA(1, 1, At, B1); PG8_BAR;
            PG8_LDB(B0, 1, 0); PG8_SCHED; PG8_LDA(At, 1, 0); PG8_STAGE(PG8_SA(0, 1), a2 + hstep, voffA);
            PG8_WAIT_L(8); PG8_BAR; PG8_WAIT_L(0); PG8_MMA(0, 0, At, B0); PG8_BAR; PG8_SCHED;
            PG8_LDB(B1, 1, 1); PG8_STAGE(PG8_SB(1, 0), b3, voffB);
            PG8_BAR; PG8_WAIT_L(0); PG8_MMA(0, 1, At, B1); PG8_BAR;
            PG8_LDA(At, 1, 1); PG8_STAGE(PG8_SA(1, 0), a3, voffA);
            PG8_BAR; PG8_WAIT_L(0); PG8_MMA(1, 0, At, B0); PG8_BAR; PG8_SCHED;
            PG8_STAGE(PG8_SB(1, 1), b3 + hstep, voffB);
            PG8_WAIT_V(6); PG8_BAR; PG8_MMA(1, 1, At, B1); PG8_BAR;
            }
        }
        if constexpr (ALIGN_EPI) { if (wr == 0) PG8_BAR; }
        if constexpr (!Epi::AFTER_DRAIN) { E(acc, cur, wr, wc, fr, fq); S.done(cur); }
        if (!has_next) break;
#pragma unroll
        for (int a = 0; a < 2; ++a)
#pragma unroll
            for (int b = 0; b < 2; ++b)
#pragma unroll
                for (int m = 0; m < 4; ++m)
#pragma unroll
                    for (int n = 0; n < 2; ++n) acc[a][b][m][n] = (f32x4){0.f, 0.f, 0.f, 0.f};
        cur = nxt; cA = nA; cB = nB; ++ui;
        if constexpr (ALIGN_EPI) { if (wr == 1) PG8_BAR; }
    }
    PG8_WAIT_V(0);
    if constexpr (!ALIGN_EPI) { if (wr == 0) PG8_BAR; }
    PG8_BAR;
    if constexpr (Epi::AFTER_DRAIN) { E.fused(acc, cur, wr, wc, fr, fq, lds, wid, lane); S.done(cur); }
#undef PG8_SA
#undef PG8_SB
#undef PG8_STAGE
#undef PG8_LDA
#undef PG8_LDB
#undef PG8_MMA
#undef PG8_WAIT_V
#undef PG8_WAIT_L
#undef PG8_BAR
#undef PG8_SCHED
}
}

constexpr int DM = 1024, DV = 2048, DFF = 2816, NGV = 2 * DFF, NIN = 2 * DV;
constexpr int MP = 16384, MS = 512, MT = MP + MS;
constexpr int SEQ = 2048;
constexpr float EPS = 1e-6f;
constexpr int NWAVES = 8;
constexpr int NPHASE = 18;

constexpr size_t O_Y = 0, O_GV = 17301504, O_PP = 19398656, O_PS = 19644416, O_CP = 23576576, O_CS = 23756800, O_END = 26640384;

constexpr size_t MiB = 1u << 20;
constexpr size_t WS_CTL = 0, CTL_ZERO_BYTES = 65536;
constexpr size_t WS_RSS0 = 1 * MiB, WS_RSS1 = 3 * MiB, RSSS_OFF = MiB / 2;
constexpr size_t WS_VSS = 5 * MiB;
constexpr size_t WS_WIN = 8 * MiB, WS_WOUT = 24 * MiB, WS_WGV = 32 * MiB, WS_WDN = 76 * MiB, WS_WPL = 98 * MiB;
constexpr size_t WS_XB = 99 * MiB;
constexpr size_t WS_U = 132 * MiB, WS_V = 198 * MiB;
constexpr size_t WS_GT = WS_U;
constexpr size_t WS_TAIL = 224 * MiB, WS_HEAD = 230 * MiB;
constexpr size_t WS_XH = 244 * MiB;
constexpr size_t WS_WM = 264 * MiB;
constexpr size_t WS_END = 265 * MiB;

constexpr int LDS_BYTES = 155648;
constexpr int MISC_OFF = 155648 - 256;

#define GAS __attribute__((address_space(1)))
#define LAS __attribute__((address_space(3)))
typedef unsigned short bf16;
typedef unsigned v4u __attribute__((ext_vector_type(4)));
typedef unsigned v2u __attribute__((ext_vector_type(2)));
typedef float f32x4 __attribute__((ext_vector_type(4)));
typedef float f32x2 __attribute__((ext_vector_type(2)));
typedef short bf16x8 __attribute__((ext_vector_type(8)));
typedef __bf16 bf16x2_t __attribute__((ext_vector_type(2)));
#define LDS_WAIT() asm volatile("s_waitcnt lgkmcnt(0)" ::: "memory")
#define VM_WAIT() asm volatile("s_waitcnt vmcnt(0)" ::: "memory")

__device__ __forceinline__ unsigned pk2(float lo, float hi) { f32x2 v = {lo, hi}; bf16x2_t b = __builtin_convertvector(v, bf16x2_t); return __builtin_bit_cast(unsigned, b); }
__device__ __forceinline__ float bf_lo(unsigned w) { return __builtin_bit_cast(float, w << 16); }
__device__ __forceinline__ float bf_hi(unsigned w) { return __builtin_bit_cast(float, w & 0xffff0000u); }
__device__ __forceinline__ float wave_sum(float v) {
#pragma unroll
    for (int o = 1; o < 64; o <<= 1) v += __shfl_xor(v, o);
    return v;
}
__device__ __forceinline__ float sum4(f32x4 a) { return (a.x + a.y) + (a.z + a.w); }
__device__ __forceinline__ float dot4(f32x4 a) { return (a.x * a.x + a.y * a.y) + (a.z * a.z + a.w * a.w); }
template <bool PROMPT> __device__ __forceinline__ float rowscale(const float* rss, int row) {
    float s;
    if (PROMPT) s = sum4(*(const f32x4*)(rss + (size_t)row * 4));
    else { const f32x4* p = (const f32x4*)(rss + RSSS_OFF / 4 + (size_t)(row - MP) * 16); s = (sum4(p[0]) + sum4(p[1])) + (sum4(p[2]) + sum4(p[3]));
           asm volatile("" : "+v"(s) :: "memory"); }
    return __builtin_amdgcn_rsqf(s * (1.0f / 1024.0f) + EPS);
}
__device__ __forceinline__ float gelu_t(float x) {
    const float e = __builtin_amdgcn_exp2f(x * (-2.3022082f + -0.1029432f * x * x));
    return x * __builtin_amdgcn_rcpf(1.0f + e);
}
__device__ __forceinline__ float silu_f(float x) {
    const float e = __builtin_amdgcn_exp2f(x * -1.4426950409f);
    return x * __builtin_amdgcn_rcpf(1.0f + e);
}
template <int CTRL> __device__ __forceinline__ float dppf(float old, float src) {
    return __builtin_bit_cast(float, __builtin_amdgcn_update_dpp(__builtin_bit_cast(int, old), __builtin_bit_cast(int, src), CTRL, 0xf, 0xf, false));
}


struct EpiG1 {
    static constexpr bool PERM = true, AFTER_DRAIN = false;
    bf16* U; bf16* V; const float* rss; float* vss;
    __device__ __forceinline__ void operator()(const f32x4 (&acc)[2][2][4][2], const pg8::Unit& u, int wr, int wc, int fr, int fq) const {
        const bool isv = u.pn >= 8;
        bf16* base = isv ? V : U;
        const int col0 = (u.pn & 7) * 256 + wc * 32 + 8 * fq;
#pragma unroll
        for (int ai = 0; ai < 2; ++ai) {
            float rrs[4];
            if (u.pm < 64) {
#pragma unroll
                for (int m = 0; m < 4; ++m) rrs[m] = rowscale<true>(rss, u.pm * 256 + ai * 128 + wr * 64 + m * 16 + fr);
            } else {
#pragma unroll
                for (int m = 0; m < 4; ++m) rrs[m] = rowscale<false>(rss, u.pm * 256 + ai * 128 + wr * 64 + m * 16 + fr);
            }
#pragma unroll
            for (int m = 0; m < 4; ++m) {
                const int row = u.pm * 256 + ai * 128 + wr * 64 + m * 16 + fr;
                const float rr = rrs[m];
                float ss = 0.f;
                bf16* rowp = base + (size_t)row * DV + col0;
#pragma unroll
                for (int bj = 0; bj < 2; ++bj) {
                    f32x4 v0 = acc[ai][bj][m][0] * rr, v1 = acc[ai][bj][m][1] * rr;
#pragma unroll
                    for (int j = 0; j < 4; ++j) { v0[j] = gelu_t(v0[j]); v1[j] = gelu_t(v1[j]); }
                    ss += dot4(v0) + dot4(v1);
                    v4u w; w.x = pk2(v0[0], v0[1]); w.y = pk2(v0[2], v0[3]); w.z = pk2(v1[0], v1[1]); w.w = pk2(v1[2], v1[3]);
                    *(v4u*)(rowp + bj * 128) = w;
                }
                if (isv) {
                    ss += __shfl_xor(ss, 16); ss += __shfl_xor(ss, 32);
                    if (fq == 0) vss[(size_t)row * 32 + (u.pn - 8) * 4 + wc] = ss;
                }
            }
        }
    }
};

struct EpiRes {
    static constexpr bool PERM = true, AFTER_DRAIN = false;
    bf16* XB; float* rss_out; bf16* xh; int dry; LAS float* red;
    __device__ __forceinline__ void operator()(const f32x4 (&acc)[2][2][4][2], const pg8::Unit& u, int wr, int wc, int fr, int fq) const {
        if (dry) return;
        const int col0 = u.pn * 256 + wc * 32 + 8 * fq;
        bf16* base = XB + (size_t)(u.pm * 256 + wr * 64 + fr) * DM + col0;
#pragma unroll
        for (int ai = 0; ai < 2; ++ai) {
            v4u xo[4][2];
#pragma unroll
            for (int m = 0; m < 4; ++m)
#pragma unroll
                for (int bj = 0; bj < 2; ++bj) xo[m][bj] = *(const v4u*)(base + (size_t)(ai * 128 + m * 16) * DM + bj * 128);
#pragma unroll
            for (int m = 0; m < 4; ++m) {
                const int row = u.pm * 256 + ai * 128 + wr * 64 + m * 16 + fr;
                bf16* br = base + (size_t)(ai * 128 + m * 16) * DM;
                float ss = 0.f;
                const bool hal = xh != nullptr && (row & 255) >= 241 && u.pm < 63;
                bf16* hr = xh + ((size_t)(u.pm + 1) * 15 + ((row & 255) - 241)) * DM + col0;
#pragma unroll
                for (int bj = 0; bj < 2; ++bj) {
                    const v4u q = xo[m][bj];
                    f32x4 x0 = {bf_lo(q.x), bf_hi(q.x), bf_lo(q.y), bf_hi(q.y)}, x1 = {bf_lo(q.z), bf_hi(q.z), bf_lo(q.w), bf_hi(q.w)};
                    x0 += acc[ai][bj][m][0]; x1 += acc[ai][bj][m][1];
                    ss += dot4(x0) + dot4(x1);
                    v4u w; w.x = pk2(x0[0], x0[1]); w.y = pk2(x0[2], x0[3]); w.z = pk2(x1[0], x1[1]); w.w = pk2(x1[2], x1[3]);
                    *(v4u*)(br + bj * 128) = w;
                    if (hal) *(v4u*)(hr + bj * 128) = w;
                }
                ss += __shfl_xor(ss, 16); ss += __shfl_xor(ss, 32);
                if (fq == 0) red[(ai * 128 + wr * 64 + m * 16 + fr) * 4 + wc] = ss;
            }
        }
        LDS_WAIT(); __builtin_amdgcn_s_barrier(); asm volatile("" ::: "memory");
        const int t = (wr * 4 + wc) * 64 + fq * 16 + fr;
        if (t < 256) { const f32x4 v = *(const LAS f32x4*)(red + t * 4); rss_out[(size_t)(u.pm * 256 + t) * 4 + u.pn] = sum4(v); }
    }
};

struct EpiGate {
    static constexpr bool PERM = true, AFTER_DRAIN = false;
    unsigned char* ws; float* out; const float* rss; const float* cw; const float* cb; const float* state; int layer;
    template <bool PROMPT>
    __device__ __forceinline__ void body(const f32x4 (&acc)[2][2][4][2], const pg8::Unit& u, int wr, int wc, int fr, int fq) const {
        bf16* GT = (bf16*)(ws + WS_GT); float* tail = (float*)(ws + WS_TAIL); float* head = (float*)(ws + WS_HEAD);
        float* out_cp = out + O_CP + (size_t)layer * 8 * 2 * DFF; float* out_cs = out + O_CS + (size_t)layer * 128 * 2 * DFF;
        const int f0 = u.pn * 128 + wc * 32 + 8 * fq;
        f32x4 w0[2], w1[2], w2[2], bb[2];
#pragma unroll
        for (int n = 0; n < 2; ++n) { w0[n] = *(const f32x4*)(cw + f0 + 4 * n); w1[n] = *(const f32x4*)(cw + DFF + f0 + 4 * n); w2[n] = *(const f32x4*)(cw + 2 * DFF + f0 + 4 * n); bb[n] = *(const f32x4*)(cb + f0 + 4 * n); }
#pragma unroll
        for (int ai = 0; ai < 2; ++ai) {
            float rrs[4];
#pragma unroll
            for (int m = 0; m < 4; ++m) rrs[m] = rowscale<PROMPT>(rss, u.pm * 256 + ai * 128 + wr * 64 + m * 16 + fr);
            f32x4 prev[2];
            prev[0] = (f32x4){0.f, 0.f, 0.f, 0.f}; prev[1] = prev[0];
#pragma unroll
            for (int m = 0; m < 4; ++m) {
                const int row = u.pm * 256 + ai * 128 + wr * 64 + m * 16 + fr;
                f32x4 a[2], v[2], g[2];
#pragma unroll
                for (int n = 0; n < 2; ++n) {
                    a[n] = acc[ai][0][m][n] * rrs[m]; v[n] = acc[ai][1][m][n] * rrs[m];
                    f32x4 a1, a2;
                    if (PROMPT) {
#pragma unroll
                        for (int k = 0; k < 4; ++k) {
                            const float t1 = dppf<0x121>(0.f, prev[n][k]), t2 = dppf<0x122>(0.f, prev[n][k]);
                            a1[k] = dppf<0x111>(t1, a[n][k]);
                            a2[k] = dppf<0x112>(t2, a[n][k]);
                        }
                    } else {
                        const int bs = (row - MP) >> 2, t = fr & 3;
                        const float* s0p = state + ((size_t)bs * 2 + 0) * DFF + f0 + 4 * n;
                        const f32x4 s0 = *(const f32x4*)s0p, s1 = *(const f32x4*)(s0p + DFF);
#pragma unroll
                        for (int k = 0; k < 4; ++k) {
                            const float x1 = dppf<0x111>(0.f, a[n][k]), x2 = dppf<0x112>(0.f, a[n][k]);
                            a1[k] = (t == 0) ? s1[k] : x1;
                            a2[k] = (t == 0) ? s0[k] : ((t == 1) ? s1[k] : x2);
                        }
                    }
                    const f32x4 cv = bb[n] + w0[n] * a2 + w1[n] * a1 + w2[n] * a[n];
#pragma unroll
                    for (int k = 0; k < 4; ++k) g[n][k] = silu_f(cv[k]) * v[n][k];
                    prev[n] = a[n];
                }
                v4u w; w.x = pk2(g[0][0], g[0][1]); w.y = pk2(g[0][2], g[0][3]); w.z = pk2(g[1][0], g[1][1]); w.w = pk2(g[1][2], g[1][3]);
                *(v4u*)(GT + (size_t)row * DFF + f0) = w;
                if (PROMPT) {
                    const int G = row >> 6;
                    if (m == 0 && fr < 2) { float* hp = head + ((size_t)G * 4 + fr) * DFF + f0; *(f32x4*)hp = a[0]; *(f32x4*)(hp + 4) = a[1]; *(f32x4*)(hp + 2 * DFF) = v[0]; *(f32x4*)(hp + 2 * DFF + 4) = v[1]; }
                    if (m == 3 && fr >= 14) {
                        float* tp = tail + ((size_t)G * 2 + (fr - 14)) * DFF + f0; *(f32x4*)tp = a[0]; *(f32x4*)(tp + 4) = a[1];
                        if ((row & (SEQ - 1)) >= SEQ - 2) { float* op = out_cp + ((size_t)(row >> 11) * 2 + (fr - 14)) * DFF + f0; *(f32x4*)op = a[0]; *(f32x4*)(op + 4) = a[1]; }
                    }
                } else {
                    const int t = fr & 3;
                    if (t >= 2) { float* op = out_cs + ((size_t)((row - MP) >> 2) * 2 + (t - 2)) * DFF + f0; *(f32x4*)op = a[0]; *(f32x4*)(op + 4) = a[1]; }
                }
            }
        }
    }
    __device__ __forceinline__ void operator()(const f32x4 (&acc)[2][2][4][2], const pg8::Unit& u, int wr, int wc, int fr, int fq) const {
        if (u.pm < 64) body<true>(acc, u, wr, wc, fr, fq); else body<false>(acc, u, wr, wc, fr, fq);
    }
};
#define XB_TMO      128
#define XB_XCNT(j)  (256  + 64 * (j))
#define XB_XSUB(j)  (1280 + 64 * (j))
#define XB_XGEN(j)  (2304 + 64 * (j))
#define XB_TOP      3328
#define XB_TOPGEN   3392
#define XCD_BAR_WORDS 3456
#define XB_SPIN_CAP (1u << 18)

__device__ __forceinline__ unsigned xb_ld(unsigned* p)              { return __hip_atomic_load(p, __ATOMIC_RELAXED, __HIP_MEMORY_SCOPE_AGENT); }
__device__ __forceinline__ unsigned xb_add(unsigned* p, unsigned v) { return __hip_atomic_fetch_add(p, v, __ATOMIC_RELAXED, __HIP_MEMORY_SCOPE_AGENT); }
__device__ __forceinline__ unsigned xb_xcc_id() { return (unsigned)__builtin_amdgcn_s_getreg((3 << 11) | 20) & 0xFu; }
#define XB_SPIN(cond, bar) do { unsigned _sp = 0; while (cond) { __builtin_amdgcn_s_sleep(1); \
    if ((++_sp & 255u) == 0u) { if (xb_ld(&(bar)[XB_TMO])) break; if (_sp > XB_SPIN_CAP) { atomicAdd(&(bar)[XB_TMO], 1u); break; } } } } while (0)

struct XcdBarrier {
    unsigned* bar; unsigned x;
    volatile LAS unsigned* st;
};

__device__ __forceinline__ XcdBarrier xcd_barrier_post(unsigned* bar, volatile LAS unsigned* st) {
    XcdBarrier b; b.bar = bar; b.x = xb_xcc_id(); b.st = st;
    if (threadIdx.x == 0) (void)xb_add(&bar[XB_XCNT(b.x)], 1u);
    return b;
}
__device__ __forceinline__ void xcd_barrier_complete(unsigned* bar, unsigned x, unsigned& nloc, unsigned& nx) {
    const unsigned G = gridDim.x * gridDim.y * gridDim.z;
    unsigned sum, cnt, mine, sp = 0u;
    for (;;) {
        sum = 0u; cnt = 0u; mine = 0u;
#pragma unroll
        for (unsigned j = 0; j < 16; ++j) { const unsigned c = xb_ld(&bar[XB_XCNT(j)]); sum += c; cnt += (c > 0u) ? 1u : 0u; mine = (j == x) ? c : mine; }
        if (sum == G) break;
        __builtin_amdgcn_s_sleep(1);
        if ((++sp & 255u) == 0u) { if (xb_ld(&bar[XB_TMO])) break; if (sp > XB_SPIN_CAP) { atomicAdd(&bar[XB_TMO], 1u); break; } }
    }
    nloc = mine > 0u ? mine : 1u; nx = cnt > 0u ? cnt : 1u;
}

__device__ __forceinline__ void xcd_barrier(const XcdBarrier& b) {
    asm volatile("s_waitcnt vmcnt(0)" ::: "memory");
    __syncthreads();
    if (threadIdx.x == 0) {
        unsigned* bar = b.bar;
        __builtin_amdgcn_s_waitcnt(0);
        unsigned nloc = b.st[0], nx = b.st[1];
        if (nloc == 0u) { xcd_barrier_complete(bar, b.x, nloc, nx); b.st[0] = nloc; b.st[1] = nx; }
        const unsigned old = xb_add(&bar[XB_XSUB(b.x)], 1u);
        const unsigned gen = old / nloc;
        if (old + 1u == (gen + 1u) * nloc) {
            __builtin_amdgcn_fence(__ATOMIC_RELEASE, "agent");
            asm volatile("s_waitcnt vmcnt(0)" ::: "memory");
            const unsigned og = xb_add(&bar[XB_TOP], 1u);
            const unsigned tg = og / nx;
            if (og + 1u == (tg + 1u) * nx) xb_add(&bar[XB_TOPGEN], 1u);
            else XB_SPIN(xb_ld(&bar[XB_TOPGEN]) == tg, bar);
            __builtin_amdgcn_fence(__ATOMIC_ACQUIRE, "agent");
            xb_add(&bar[XB_XGEN(b.x)], 1u);
            asm volatile("s_waitcnt vmcnt(0)" ::: "memory");
        } else {
            XB_SPIN(xb_ld(&bar[XB_XGEN(b.x)]) == gen, bar);
            __builtin_amdgcn_fence(__ATOMIC_ACQUIRE, "agent");
            asm volatile("s_waitcnt vmcnt(0)" ::: "memory");
        }
    }
    __syncthreads();
}

struct Args { const float* in[19]; float* out; unsigned char* ws; int ph_lo, ph_hi, use_bar, pad; };
enum { I_XP = 0, I_XS, I_SPOOL, I_SCONV, I_NMIX, I_NFFN, I_NFIN, I_WIN, I_GV, I_WS, I_BS, I_WOUT, I_WPOOL, I_SCALE, I_WGATE, I_WVAL, I_CW, I_CB, I_WDOWN };

__device__ __forceinline__ void transpose_item(const float* W, int ldw, int K, bf16* WT, int wt_row0, const float* gk, LAS float* scr, int kb, int nb, int lane) {
    const int k0 = 64 * kb, n0 = 32 * nb;
#pragma unroll 8
    for (int i = 0; i < 32; ++i) { const int kk = 2 * i + (lane >> 5); scr[kk * 33 + (lane & 31)] = W[(size_t)(k0 + kk) * ldw + n0 + (lane & 31)]; }
    LDS_WAIT(); asm volatile("" ::: "memory");
    const int c = lane & 7;
    float g[8];
#pragma unroll
    for (int t = 0; t < 8; ++t) g[t] = gk ? gk[k0 + 8 * c + t] : 1.0f;
#pragma unroll
    for (int j = 0; j < 4; ++j) { const int n = (lane >> 3) + 8 * j; const LAS float* s = scr + (8 * c) * 33 + n;
        v4u o; o.x = pk2(s[0 * 33] * g[0], s[1 * 33] * g[1]); o.y = pk2(s[2 * 33] * g[2], s[3 * 33] * g[3]); o.z = pk2(s[4 * 33] * g[4], s[5 * 33] * g[5]); o.w = pk2(s[6 * 33] * g[6], s[7 * 33] * g[7]);
        *(v4u*)(WT + (size_t)(wt_row0 + n) * K + k0 + 8 * c) = o; }
    LDS_WAIT(); asm volatile("" ::: "memory");
}

__device__ __forceinline__ void phase_prologue(const Args& A, LAS unsigned char* lds, int G) {
    int tid_ = threadIdx.x; asm volatile("" : "+v"(tid_)); const int tid = tid_, lane = tid & 63, wave = __builtin_amdgcn_readfirstlane(tid >> 6);
    LAS float* scr = (LAS float*)(lds + wave * 16384);
    const int gw = blockIdx.x * NWAVES + wave, NGW = G * NWAVES;
    bf16* WIN = (bf16*)(A.ws + WS_WIN); bf16* WOUT = (bf16*)(A.ws + WS_WOUT); bf16* WGV = (bf16*)(A.ws + WS_WGV); bf16* WDN = (bf16*)(A.ws + WS_WDN); bf16* WPL = (bf16*)(A.ws + WS_WPL);
    constexpr int N_IN = 2 * 2048, N_OUT = 2 * 1024, N_GV = 4 * 2816, N_DN = 4 * 1408, N_PL = 8 * 32, NITEMS = N_IN + N_OUT + N_GV + N_DN + N_PL;
    for (int it = gw; it < NITEMS; it += NGW) {
        int r = it;
        if (r < N_IN) { const int j = r / 2048; r %= 2048; const int kb = r / 128, nb = r % 128;
            transpose_item(A.in[I_WIN] + (size_t)j * DM * NIN, NIN, DM, WIN + (size_t)j * NIN * DM, 32 * nb, A.in[I_NMIX] + (2 * j) * DM, scr, kb, nb, lane); continue; }
        r -= N_IN;
        if (r < N_OUT) { const int j = r / 1024; r %= 1024; const int kb = r / 32, nb = r % 32;
            transpose_item(A.in[I_WOUT] + (size_t)j * DV * DM, DM, DV, WOUT + (size_t)j * DM * DV, 32 * nb, nullptr, scr, kb, nb, lane); continue; }
        r -= N_OUT;
        if (r < N_GV) { const int i = r / 2816; r %= 2816; const int isval = r / 1408; r %= 1408; const int kb = r / 88, nb = r % 88; const int f0 = 32 * nb;
            transpose_item((isval ? A.in[I_WVAL] : A.in[I_WGATE]) + (size_t)i * DM * DFF, DFF, DM, WGV + (size_t)i * NGV * DM, 256 * (f0 >> 7) + 128 * isval + (f0 & 127), A.in[I_NFFN] + i * DM, scr, kb, nb, lane); continue; }
        r -= N_GV;
        if (r < N_DN) { const int i = r / 1408; r %= 1408; const int kb = r / 32, nb = r % 32;
            transpose_item(A.in[I_WDOWN] + (size_t)i * DFF * DM, DM, DFF, WDN + (size_t)i * DM * DFF, 32 * nb, nullptr, scr, kb, nb, lane); continue; }
        r -= N_DN;
        { const int jg = r / 32; r %= 32; const int kb = r / 8, nb = r % 8;
            transpose_item(A.in[I_WPOOL] + (size_t)jg * 65536, 256, 256, WPL + (size_t)jg * 65536, 32 * nb, nullptr, scr, kb, nb, lane); }
    }
    bf16* XB = (bf16*)(A.ws + WS_XB); float* rss0 = (float*)(A.ws + WS_RSS0);
    for (int m = gw; m < MT; m += NGW) {
        const float* src = m < MP ? A.in[I_XP] + (size_t)m * DM : A.in[I_XS] + (size_t)(m - MP) * DM;
        f32x4 v[4]; float ss[4];
#pragma unroll
        for (int j = 0; j < 4; ++j) { v[j] = *(const f32x4*)(src + 256 * j + 4 * lane); ss[j] = wave_sum(dot4(v[j])); }
#pragma unroll
        for (int j = 0; j < 4; ++j) { v2u w; w.x = pk2(v[j][0], v[j][1]); w.y = pk2(v[j][2], v[j][3]); *(v2u*)(XB + (size_t)m * DM + 256 * j + 4 * lane) = w; }
        if (m < MP) { if (lane == 0) *(f32x4*)(rss0 + (size_t)m * 4) = (f32x4){ss[0], ss[1], ss[2], ss[3]}; }
        else if (lane < 16) { const int q = lane >> 2; const float sv = q == 0 ? ss[0] : (q == 1 ? ss[1] : (q == 2 ? ss[2] : ss[3])); rss0[RSSS_OFF / 4 + (size_t)(m - MP) * 16 + lane] = (lane & 3) == 0 ? sv : 0.f; }
    }
    { const float* wsa = A.in[I_WS]; bf16* wm = (bf16*)(A.ws + WS_WM);
      for (int idx = blockIdx.x * 512 + tid; idx < 2 * 2 * 8 * 16384; idx += G * 512) { const int j = idx & 127, i = (idx >> 7) & 127, h = (idx >> 14) & 7, var = (idx >> 17) & 1, l = idx >> 18;
          const float* wh = wsa + ((size_t)l * 8 + h) * 16384; float w;
          if (var == 0) w = (j <= i) ? wh[i * 128 + j] : 0.f;
          else w = ((i >> 2) == (j >> 2) && (j & 3) <= (i & 3)) ? wh[(i & 3) * 128 + (j & 3)] : 0.f;
          wm[idx] = (bf16)(pk2(w, 0.f) & 0xffffu); } }
    { const f32x4* sp = (const f32x4*)A.in[I_SPOOL]; f32x4* op = (f32x4*)(A.out + O_PS);
      const size_t tot = (size_t)256 * 2816, stride = (size_t)G * 512;
      for (size_t i = (size_t)blockIdx.x * 512 + tid; i < tot; i += stride) { const size_t jb = i / 2816, r = i % 2816; op[jb * 3840 + r] = sp[jb * 3840 + 1024 + r]; } }
}

__device__ __forceinline__ unsigned vs_off(unsigned row, unsigned ch) { return 256u * row + 16u * (ch ^ (((row & 3u) << 2) | ((row >> 2) & 3u))); }
typedef short v4i16_t __attribute__((ext_vector_type(4)));
__device__ __forceinline__ void phase_spatial(const Args& A, LAS unsigned char* lds, int G, int jl, int dry) {
    int tid_ = threadIdx.x; asm volatile("" : "+v"(tid_)); const int tid = tid_, lane = tid & 63, wave = __builtin_amdgcn_readfirstlane(tid >> 6), fr = lane & 15, fq = lane >> 4;
    LAS unsigned char* VS = lds;
    LAS bf16* WM = (LAS bf16*)(lds + 65536);
    LAS float* RV = (LAS float*)(lds + 65536 + 34816);
    bf16* U = (bf16*)(A.ws + WS_U); const bf16* V = (const bf16*)(A.ws + WS_V); const float* vss = (const float*)(A.ws + WS_VSS);
    const bf16* wmp = (const bf16*)(A.ws + WS_WM) + (size_t)jl * 2 * 8 * 16384;
    const float* bsv = A.in[I_BS] + jl * 8 * 128; const float* gv = A.in[I_GV] + jl * DV;
    float* ogv = A.out + O_GV + (size_t)jl * MS * DV;
    const unsigned tq = (lane & 15) >> 2, tp = lane & 3;
    for (int item = blockIdx.x; item < 132 * 8; item += G) {
        const int c = item >> 3, h = item & 7, R0 = 128 * c; const bool sample = c >= 128;
        if (tid < 128) { const f32x4* p = (const f32x4*)(vss + (size_t)(R0 + tid) * 32); float s = 0.f;
#pragma unroll
            for (int q = 0; q < 8; ++q) s += sum4(p[q]);
            RV[tid] = __builtin_amdgcn_rsqf(s * (1.0f / 2048.0f) + EPS); }
#pragma unroll
        for (int it = 0; it < 8; ++it) { const int idx = tid + 512 * it, j = idx >> 5, c16 = idx & 31;
            const v4u v = *(const v4u*)(V + (size_t)(R0 + j) * DV + 256 * h + 8 * c16);
            *(LAS v4u*)(VS + (c16 >> 4) * 32768 + vs_off(j, c16 & 15)) = v; }
        __syncthreads();
        const bf16* wh = wmp + ((size_t)(sample ? 8 : 0) + h) * 16384;
#pragma unroll
        for (int it = 0; it < 4; ++it) { const int idx = tid + 512 * it, i = idx >> 4, j8 = (idx & 15) * 8;
            const v4u w = *(const v4u*)(wh + i * 128 + j8);
            const f32x4 ra = *(const LAS f32x4*)(RV + j8), rb = *(const LAS f32x4*)(RV + j8 + 4);
            v4u o; o.x = pk2(bf_lo(w.x) * ra[0], bf_hi(w.x) * ra[1]); o.y = pk2(bf_lo(w.y) * ra[2], bf_hi(w.y) * ra[3]);
            o.z = pk2(bf_lo(w.z) * rb[0], bf_hi(w.z) * rb[1]); o.w = pk2(bf_lo(w.w) * rb[2], bf_hi(w.w) * rb[3]);
            *(LAS v4u*)(WM + i * 136 + j8) = o; }
        __syncthreads();
        f32x4 acc[8][2];
#pragma unroll
        for (int rb = 0; rb < 8; ++rb) { acc[rb][0] = (f32x4){0.f, 0.f, 0.f, 0.f}; acc[rb][1] = (f32x4){0.f, 0.f, 0.f, 0.f}; }
        LAS unsigned char* vsub = VS + (wave >> 2) * 32768;
#pragma unroll
        for (int ks = 0; ks < 4; ++ks) {
            bf16x8 bfr[2];
#pragma unroll
            for (int cb = 0; cb < 2; ++cb) {
                const unsigned r0 = 32 * ks + 8 * fq + tq, ch = 4 * (wave & 3) + tp;
                const v4i16_t lo = __builtin_amdgcn_ds_read_tr16_b64_v4i16((LAS v4i16_t*)(vsub + vs_off(r0, ch) + 8 * cb));
                const v4i16_t hi = __builtin_amdgcn_ds_read_tr16_b64_v4i16((LAS v4i16_t*)(vsub + vs_off(r0 + 4, ch) + 8 * cb));
                bfr[cb] = (bf16x8){lo[0], lo[1], lo[2], lo[3], hi[0], hi[1], hi[2], hi[3]};
            }
#pragma unroll
            for (int rb = 0; rb < 8; ++rb) { const bf16x8 afr = *(const LAS bf16x8*)(WM + (16 * rb + fr) * 136 + 32 * ks + 8 * fq);
                acc[rb][0] = __builtin_amdgcn_mfma_f32_16x16x32_bf16(bfr[0], afr, acc[rb][0], 0, 0, 0);
                acc[rb][1] = __builtin_amdgcn_mfma_f32_16x16x32_bf16(bfr[1], afr, acc[rb][1], 0, 0, 0); }
        }
        const int e = 256 * h + 32 * wave + 8 * fq;
        const f32x4 g0 = *(const f32x4*)(gv + e), g1 = *(const f32x4*)(gv + e + 4);
#pragma unroll
        for (int rb = 0; rb < 8; ++rb) { const int i = 16 * rb + fr, row = R0 + i; const float bi = bsv[h * 128 + (sample ? (i & 3) : i)];
            bf16* up = U + (size_t)row * DV + e; const v4u uu = *(const v4u*)up;
            const f32x4 s0 = g0 * acc[rb][0] + bi, s1 = g1 * acc[rb][1] + bi;
            v4u w; w.x = pk2(bf_lo(uu.x) * s0[0], bf_hi(uu.x) * s0[1]); w.y = pk2(bf_lo(uu.y) * s0[2], bf_hi(uu.y) * s0[3]);
            w.z = pk2(bf_lo(uu.z) * s1[0], bf_hi(uu.z) * s1[1]); w.w = pk2(bf_lo(uu.w) * s1[2], bf_hi(uu.w) * s1[3]);
            if (!dry) *(v4u*)up = w; }
        if (sample && !dry) {
            for (int idx = tid; idx < 4096; idx += 512) { const int j = idx >> 5, e8 = (idx & 31) * 8; const int ee = 256 * h + e8;
                const v4u v = *(const v4u*)(V + (size_t)(R0 + j) * DV + ee); const float rv = RV[j];
                const f32x4 ga = *(const f32x4*)(gv + ee), gb = *(const f32x4*)(gv + ee + 4);
                float* o = ogv + (size_t)(R0 - MP + j) * DV + ee;
                *(f32x4*)o = (f32x4){bf_lo(v.x) * rv * ga[0], bf_hi(v.x) * rv * ga[1], bf_lo(v.y) * rv * ga[2], bf_hi(v.y) * rv * ga[3]};
                *(f32x4*)(o + 4) = (f32x4){bf_lo(v.z) * rv * gb[0], bf_hi(v.z) * rv * gb[1], bf_lo(v.w) * rv * gb[2], bf_hi(v.w) * rv * gb[3]}; }
        }
        __syncthreads();
    }
}

__device__ __forceinline__ void fixup_tile(const Args& A, int pm, int layer) {
    const float* tail = (const float*)(A.ws + WS_TAIL); const float* head = (const float*)(A.ws + WS_HEAD); bf16* GT = (bf16*)(A.ws + WS_GT);
    const float* cw = A.in[I_CW] + (size_t)layer * 3 * DFF; const float* cb = A.in[I_CB] + (size_t)layer * DFF;
    for (int idx = threadIdx.x; idx < 4 * 2 * 704; idx += 512) {
        const int Gr = 4 * pm + idx / 1408, rem = idx % 1408, r = rem / 704, f = 4 * (rem % 704);
        if ((Gr & 31) == 0) continue;
        const f32x4 t0 = *(const f32x4*)(tail + ((size_t)(Gr - 1) * 2 + 0) * DFF + f), t1 = *(const f32x4*)(tail + ((size_t)(Gr - 1) * 2 + 1) * DFF + f);
        const f32x4 h0 = *(const f32x4*)(head + ((size_t)Gr * 4 + 0) * DFF + f), h1 = *(const f32x4*)(head + ((size_t)Gr * 4 + 1) * DFF + f);
        const f32x4 vv = *(const f32x4*)(head + ((size_t)Gr * 4 + 2 + r) * DFF + f);
        const f32x4 w0 = *(const f32x4*)(cw + f), w1 = *(const f32x4*)(cw + DFF + f), w2 = *(const f32x4*)(cw + 2 * DFF + f), bb = *(const f32x4*)(cb + f);
        const f32x4 cv = r == 0 ? bb + w0 * t0 + w1 * t1 + w2 * h0 : bb + w0 * t1 + w1 * h0 + w2 * h1;
        v2u w; w.x = pk2(silu_f(cv[0]) * vv[0], silu_f(cv[1]) * vv[1]); w.y = pk2(silu_f(cv[2]) * vv[2], silu_f(cv[3]) * vv[3]);
        *(v2u*)(GT + (size_t)(64 * Gr + r) * DFF + f) = w;
    }
}

__device__ __forceinline__ void sample_res_gemm(LAS unsigned char* lds, const bf16* Amat, const bf16* Bt, int K, bf16* XB, float* rss_out, int sdry) {
    int tid_ = threadIdx.x; asm volatile("" : "+v"(tid_)); const int tid = tid_, lane = tid & 63, wave = __builtin_amdgcn_readfirstlane(tid >> 6), fr = lane & 15, fq = lane >> 4;
    LAS f32x4* red = (LAS f32x4*)lds;
    LAS float* r2 = (LAS float*)(lds + 65536);
    for (int item = blockIdx.x; item < 256; item += gridDim.x) {
        const int sr = item >> 4, sc = item & 15, kw = K >> 3, nks = kw >> 5;
        const bf16* ap = Amat + (size_t)(MP + 32 * sr + fr) * K + wave * kw + 8 * fq;
        const bf16* bp = Bt + (size_t)(64 * sc + fr) * K + wave * kw + 8 * fq;
        f32x4 acc[2][4];
#pragma unroll
        for (int rb = 0; rb < 2; ++rb)
#pragma unroll
            for (int cb = 0; cb < 4; ++cb) acc[rb][cb] = (f32x4){0.f, 0.f, 0.f, 0.f};
#pragma unroll 4
        for (int ks = 0; ks < nks; ++ks) {
            const bf16x8 a0 = *(const bf16x8*)(ap + 32 * ks), a1 = *(const bf16x8*)(ap + (size_t)16 * K + 32 * ks);
            bf16x8 b[4];
#pragma unroll
            for (int cb = 0; cb < 4; ++cb) b[cb] = *(const bf16x8*)(bp + (size_t)(16 * cb) * K + 32 * ks);
#pragma unroll
            for (int cb = 0; cb < 4; ++cb) { acc[0][cb] = __builtin_amdgcn_mfma_f32_16x16x32_bf16(b[cb], a0, acc[0][cb], 0, 0, 0);
                                             acc[1][cb] = __builtin_amdgcn_mfma_f32_16x16x32_bf16(b[cb], a1, acc[1][cb], 0, 0, 0); }
        }
#pragma unroll
        for (int rb = 0; rb < 2; ++rb)
#pragma unroll
            for (int cb = 0; cb < 4; ++cb) red[(wave * 8 + rb * 4 + cb) * 64 + lane] = acc[rb][cb];
        __syncthreads();
        f32x4 s = red[wave * 64 + lane];
#pragma unroll
        for (int w = 1; w < 8; ++w) s += red[(w * 8 + wave) * 64 + lane];
        const int rb = wave >> 2, cb = wave & 3, row = MP + 32 * sr + 16 * rb + fr, col = 64 * sc + 16 * cb + 4 * fq;
        bf16* xp = XB + (size_t)row * DM + col; const v2u xo = *(const v2u*)xp;
        const f32x4 x = (f32x4){bf_lo(xo.x), bf_hi(xo.x), bf_lo(xo.y), bf_hi(xo.y)} + s;
        v2u w; w.x = pk2(x[0], x[1]); w.y = pk2(x[2], x[3]); if (!sdry) *(v2u*)xp = w;
        float ss = dot4(x); ss += __shfl_xor(ss, 16); ss += __shfl_xor(ss, 32);
        if (fq == 0) r2[(16 * rb + fr) * 4 + cb] = ss;
        __syncthreads();
        if (tid < 32 && !sdry) rss_out[RSSS_OFF / 4 + (size_t)(32 * sr + tid) * 16 + sc] = sum4(*(const LAS f32x4*)(r2 + tid * 4));
        __syncthreads();
    }
}

__device__ __forceinline__ void phase_pool(const Args& A, LAS unsigned char* lds, int G, int layer, const float* rss_in, float* rss_out, int dry) {
    int tid_ = threadIdx.x; asm volatile("" : "+v"(tid_)); const int tid = tid_, lane = tid & 63, wave = __builtin_amdgcn_readfirstlane(tid >> 6), fr = lane & 15, fq = lane >> 4;
    const int jl = layer >> 1;
    LAS bf16* P = (LAS bf16*)lds;
    LAS float* RR = (LAS float*)(lds + 143616);
    LAS float* RED = (LAS float*)(lds + 143616 + 1280);
    bf16* XB = (bf16*)(A.ws + WS_XB); const bf16* XH = (const bf16*)(A.ws + WS_XH);
    const float* gain = A.in[I_NMIX] + (size_t)layer * DM; const float* scale = A.in[I_SCALE] + (size_t)jl * DM;
    const float* spool = A.in[I_SPOOL] + (size_t)jl * 128 * 15 * DM;
    float* opp = A.out + O_PP + (size_t)jl * 8 * 15 * DM; float* ops = A.out + O_PS + (size_t)jl * 128 * 15 * DM;
    for (int item = blockIdx.x; item < 256; item += G) {
        const int slot = item >> 2, g = item & 3, W = 2 << g, R0 = 256 * slot;
        const bool seq_start = (slot & 7) == 0, seq_end = (slot & 7) == 7;
        const bf16* wp = (const bf16*)(A.ws + WS_WPL) + ((size_t)jl * 4 + g) * 65536;
        bf16x8 bfr[2][8];
#pragma unroll
        for (int cb = 0; cb < 2; ++cb)
#pragma unroll
            for (int ks = 0; ks < 8; ++ks) bfr[cb][ks] = *(const bf16x8*)(wp + (size_t)(32 * wave + 8 * (fr >> 2) + 4 * cb + (fr & 3)) * 256 + 32 * ks + 8 * fq);
        if (tid < 279) { float v;
            if (tid < 271) { const int local = tid - 15; v = (local >= 0 || !seq_start) ? rowscale<true>(rss_in, R0 + local) : 0.f; }
            else v = rowscale<false>(rss_in, MP + 8 * slot + (tid - 271));
            RR[tid] = v; }
        __syncthreads();
        const int ch = 256 * g + 4 * lane;
        const f32x4 gain4 = *(const f32x4*)(gain + ch);
        const float invW = 1.0f / (float)W;
        {
            const int r0 = 32 * wave;
            const bf16* xc = XB + (size_t)R0 * DM + ch; const bf16* xhc = XH + (size_t)slot * 15 * DM + ch;
#define LDX4(p) ({ const v2u q_ = *(const v2u*)(p); (f32x4){bf_lo(q_.x), bf_hi(q_.x), bf_lo(q_.y), bf_hi(q_.y)}; })
#define HROW(local) (((local) >= 0 ? LDX4(xc + (ptrdiff_t)(local) * DM) : (seq_start ? (f32x4){0.f, 0.f, 0.f, 0.f} : LDX4(xhc + (ptrdiff_t)((local) + 15) * DM))) * RR[(local) + 15] * gain4)
            f32x4 s = {0.f, 0.f, 0.f, 0.f};
            for (int rr = r0 - (W - 1); rr < r0; ++rr) s += HROW(rr);
#pragma unroll 8
            for (int rr = r0; rr < r0 + 32; ++rr) {
                const f32x4 a = HROW(rr); s += a;
                const int t = (R0 + rr) & (SEQ - 1); const float inv = (t + 1 < W) ? 1.0f / (float)(t + 1) : invW;
                const f32x4 pv = s * inv - a;
                v2u w; w.x = pk2(pv[0], pv[1]); w.y = pk2(pv[2], pv[3]);
                *(LAS v2u*)(P + rr * 264 + 4 * lane) = w;
                if (seq_end && rr >= 241 && !dry) *(f32x4*)(opp + ((size_t)(slot >> 3) * 15 + (rr - 241)) * DM + ch) = a;
                const int rb = rr - W + 1;
                s -= HROW(rb);
            }
#undef HROW
        }
        {
            const int srow = wave, b = 2 * slot + (srow >> 2), t = srow & 3, grow = MP + 8 * slot + srow;
            f32x4 s = {0.f, 0.f, 0.f, 0.f}, a0 = s;
            for (int d = 0; d < W; ++d) { const int k = t - d; f32x4 v;
                if (k >= 0) v = LDX4(XB + (size_t)(grow - d) * DM + ch) * RR[271 + srow - d] * gain4;
                else v = *(const f32x4*)(spool + ((size_t)b * 15 + (15 + k)) * DM + ch);
                if (d == 0) a0 = v;
                s += v; }
            const f32x4 pv = s * invW - a0;
            v2u w; w.x = pk2(pv[0], pv[1]); w.y = pk2(pv[2], pv[3]);
            *(LAS v2u*)(P + (256 + srow) * 264 + 4 * lane) = w;
            *(LAS v2u*)(P + (264 + srow) * 264 + 4 * lane) = (v2u){0u, 0u};
            if (!dry) *(f32x4*)(ops + ((size_t)b * 15 + 11 + t) * DM + ch) = a0;
        }
        __syncthreads();
        const int ce = 256 * g + 32 * wave + 8 * fq;
        const f32x4 sc0 = *(const f32x4*)(scale + ce), sc1 = *(const f32x4*)(scale + ce + 4);
#pragma unroll 2
        for (int rb = 0; rb < 17; ++rb) {
            f32x4 acc0 = {0.f, 0.f, 0.f, 0.f}, acc1 = acc0;
#pragma unroll
            for (int ks = 0; ks < 8; ++ks) { const bf16x8 afr = *(const LAS bf16x8*)(P + (16 * rb + fr) * 264 + 32 * ks + 8 * fq);
                acc0 = __builtin_amdgcn_mfma_f32_16x16x32_bf16(bfr[0][ks], afr, acc0, 0, 0, 0);
                acc1 = __builtin_amdgcn_mfma_f32_16x16x32_bf16(bfr[1][ks], afr, acc1, 0, 0, 0); }
            const int lrow = 16 * rb + fr; const bool valid = lrow < 264;
            const int grow = lrow < 256 ? R0 + lrow : (valid ? MP + 8 * slot + (lrow - 256) : 0);
            bf16* xp = XB + (size_t)grow * DM + ce;
            const v4u xo = *(const v4u*)xp;
            f32x4 x0 = {bf_lo(xo.x), bf_hi(xo.x), bf_lo(xo.y), bf_hi(xo.y)}, x1 = {bf_lo(xo.z), bf_hi(xo.z), bf_lo(xo.w), bf_hi(xo.w)};
            x0 += acc0 * sc0; x1 += acc1 * sc1;
            float ss = dot4(x0) + dot4(x1);
            ss += __shfl_xor(ss, 16); ss += __shfl_xor(ss, 32);
            if (valid && !dry) { v4u w; w.x = pk2(x0[0], x0[1]); w.y = pk2(x0[2], x0[3]); w.z = pk2(x1[0], x1[1]); w.w = pk2(x1[2], x1[3]); *(v4u*)xp = w; }
            if (fq == 0) RED[lrow * 8 + wave] = ss;
        }
        __syncthreads();
        if (tid < 264 && !dry) { const int grow = tid < 256 ? R0 + tid : MP + 8 * slot + (tid - 256);
            const LAS f32x4* rp = (const LAS f32x4*)(RED + tid * 8); const float s = sum4(rp[0]) + sum4(rp[1]);
            if (tid < 256) rss_out[(size_t)grow * 4 + g] = s;
            else *(f32x4*)(rss_out + RSSS_OFF / 4 + (size_t)(grow - MP) * 16 + 4 * g) = (f32x4){s, 0.f, 0.f, 0.f}; }
        __syncthreads();
    }
}

__device__ __forceinline__ void phase_final(const Args& A, int G) {
    int tid_ = threadIdx.x; asm volatile("" : "+v"(tid_)); const int tid = tid_, lane = tid & 63, wave = __builtin_amdgcn_readfirstlane(tid >> 6);
    float* Y = A.out + O_Y; const bf16* XB = (const bf16*)(A.ws + WS_XB); const float* gf = A.in[I_NFIN];
    for (int m = blockIdx.x * NWAVES + wave; m < MT; m += G * NWAVES) {
        f32x4 v[4]; float s = 0.f;
#pragma unroll
        for (int j = 0; j < 2; ++j) { const v4u q = *(const v4u*)(XB + (size_t)m * DM + 512 * j + 8 * lane);
            v[2 * j] = (f32x4){bf_lo(q.x), bf_hi(q.x), bf_lo(q.y), bf_hi(q.y)}; v[2 * j + 1] = (f32x4){bf_lo(q.z), bf_hi(q.z), bf_lo(q.w), bf_hi(q.w)};
            s += dot4(v[2 * j]) + dot4(v[2 * j + 1]); }
        const float rr = __builtin_amdgcn_rsqf(wave_sum(s) * (1.0f / 1024.0f) + EPS);
#pragma unroll
        for (int j = 0; j < 2; ++j) { const float* gp = gf + 512 * j + 8 * lane; float* yp = Y + (size_t)m * DM + 512 * j + 8 * lane;
            *(f32x4*)yp = v[2 * j] * rr * *(const f32x4*)gp; *(f32x4*)(yp + 4) = v[2 * j + 1] * rr * *(const f32x4*)(gp + 4); }
    }
}

enum { T_PRO = 0, T_G1, T_SP, T_G3, T_G5, T_FX, T_G6, T_PL, T_FIN };
#ifndef PHASE_MASK
#define PHASE_MASK 255
#endif
#ifndef PROBE_TYPE
#define PROBE_TYPE -1
#endif
#ifndef N_LAUNCH_SPLIT
#define N_LAUNCH_SPLIT 0
#endif

typedef const Args __attribute__((address_space(4))) KArgs;
__device__ __forceinline__ Args load_args(KArgs* kp) { Args A;
#pragma unroll
    for (int i = 0; i < 19; ++i) A.in[i] = kp->in[i];
    A.out = kp->out; A.ws = kp->ws; A.ph_lo = 0; A.ph_hi = 0; A.use_bar = 0; A.pad = 0; return A; }

__global__ void __launch_bounds__(NWAVES * 64, 2) fwd_kernel(Args args) {
    extern __shared__ __attribute__((aligned(16))) unsigned char lds_raw[];
    LAS unsigned char* lds = (LAS unsigned char*)lds_raw;
    volatile LAS unsigned* MISC = (volatile LAS unsigned*)(lds + MISC_OFF);
    const int tid = threadIdx.x, G = gridDim.x;
    if (tid < 64) MISC[tid] = 0u;
    __syncthreads();
    unsigned* barw = (unsigned*)(args.ws + WS_CTL) + 1024;
    XcdBarrier bar; bar.bar = barw; bar.x = 0; bar.st = nullptr;
    if (args.use_bar) bar = xcd_barrier_post(barw, MISC + 8);

    const int ph_lo = args.ph_lo, ph_hi = args.ph_hi;
#pragma nounroll
    for (int ph = ph_lo; ph < ph_hi; ++ph) {
        KArgs* kp = (KArgs*)__builtin_amdgcn_kernarg_segment_ptr(); asm volatile("" : "+s"(kp));
        int type, layer;
        if (ph == 0) { type = T_PRO; layer = 0; }
        else if (ph == NPHASE - 1) { type = T_FIN; layer = 0; }
        else { const int q = ph - 1, lp = q >> 3, r = q & 7;
            if (r < 5) { layer = 2 * lp; type = r == 0 ? T_G1 : (r == 1 ? T_SP : (r == 2 ? T_G3 : (r == 3 ? T_G5 : T_G6))); }
            else { layer = 2 * lp + 1; type = r == 5 ? T_PL : (r == 6 ? T_G5 : T_G6); } }
        const int jl = layer >> 1;
        const int nrep = (type == PROBE_TYPE) ? 2 : 1;
        for (int rep = 0; rep < nrep; ++rep) {
        const int dry = rep + 1 < nrep;
        if (type == T_PRO && (PHASE_MASK & 1)) { const Args A = load_args(kp); phase_prologue(A, lds, G); }
        else if (type == T_G1 && (PHASE_MASK & 2)) {
            unsigned char* ws = kp->ws;
            pg8::Gemm g{(const bf16*)(ws + WS_XB), (const bf16*)(ws + WS_WIN) + (size_t)jl * NIN * DM, MT, NIN, DM}; pg8::StaticOrder S; S.init(MT, NIN, G, (int)blockIdx.x);
            EpiG1 E{(bf16*)(ws + WS_U), (bf16*)(ws + WS_V), (const float*)(ws + WS_RSS0), (float*)(ws + WS_VSS)};
            pg8::gemm_phase<EpiG1, pg8::StaticOrder, true, true>(lds, g, S, E);
        }
        else if (type == T_SP && (PHASE_MASK & 4)) { const Args A = load_args(kp); phase_spatial(A, lds, G, jl, dry); }
        else if ((type == T_G3 || type == T_G6) && (PHASE_MASK & 8)) {
            const bool g3 = type == T_G3;
            unsigned char* ws = kp->ws;
            bf16* XB = (bf16*)(ws + WS_XB); float* rss_o = (float*)(ws + (g3 ? WS_RSS1 : WS_RSS0));
            pg8::Gemm g{(const bf16*)(ws + WS_U)  , g3 ? (const bf16*)(ws + WS_WOUT) + (size_t)jl * DM * DV : (const bf16*)(ws + WS_WDN) + (size_t)layer * DM * DFF, MP, DM, g3 ? DV : DFF};
            pg8::StaticOrder S; S.init(MP, DM, G, (int)blockIdx.x);
            if (!g3) { const Args A = load_args(kp); pg8::Unit fu; for (int ui = 0; S.next(ui, fu); ++ui) fixup_tile(A, fu.pm, layer); VM_WAIT(); __syncthreads(); }
            EpiRes E{XB, rss_o, (!g3 && (layer & 1) == 0) ? (bf16*)(ws + WS_XH) : nullptr, dry, (LAS float*)(lds + 131072)};
            pg8::gemm_phase<EpiRes, pg8::StaticOrder, true, true>(lds, g, S, E);
#ifdef PROBE_MINI
            if (!dry) sample_res_gemm(lds, g.A, g.Bt, g.K, XB, rss_o, 1);
#endif
            if (!dry) sample_res_gemm(lds, g.A, g.Bt, g.K, XB, rss_o, 0);
        }
        else if (type == T_G5 && (PHASE_MASK & 16)) {
            unsigned char* ws = kp->ws;
            pg8::Gemm g{(const bf16*)(ws + WS_XB), (const bf16*)(ws + WS_WGV) + (size_t)layer * NGV * DM, MT, NGV, DM}; pg8::StaticOrder S; S.init(MT, NGV, G, (int)blockIdx.x);
            EpiGate E{ws, kp->out, (const float*)(ws + WS_RSS1), kp->in[I_CW] + (size_t)layer * 3 * DFF, kp->in[I_CB] + (size_t)layer * DFF, kp->in[I_SCONV] + (size_t)layer * 128 * 2 * DFF, layer};
            pg8::gemm_phase<EpiGate, pg8::StaticOrder, true, true>(lds, g, S, E);
        }
        else if (type == T_PL && (PHASE_MASK & 64)) { const Args A = load_args(kp); phase_pool(A, lds, G, layer, (const float*)(A.ws + WS_RSS0), (float*)(A.ws + WS_RSS1), dry); }
        else if (PHASE_MASK & 128) { const Args A = load_args(kp); phase_final(A, G); }
        }
        if (ph + 1 < ph_hi) { xcd_barrier(bar);
#ifdef PROBE_BAR2
            xcd_barrier(bar);
#endif
        }
    }
}

extern "C" void kernel_launch(void* const* d_in, const int* in_sizes, int n_in, void* d_out, int out_size, void* d_ws, size_t ws_size, hipStream_t stream) {
    static int grid = 0;
    if (grid == 0) {
        if (n_in != 19 || (size_t)out_size != O_END || ws_size < WS_END) { fprintf(stderr, "kernel_launch: unexpected shapes: n_in %d out %d ws %zu (need %zu); nothing launched\n", n_in, out_size, ws_size, (size_t)WS_END); grid = -1; return; }
        int dev = 0, cus = 0, per_cu = 0;
        if (hipGetDevice(&dev) != hipSuccess || hipDeviceGetAttribute(&cus, hipDeviceAttributeMultiprocessorCount, dev) != hipSuccess) { grid = -1; return; }
        if (hipFuncSetAttribute((const void*)fwd_kernel, hipFuncAttributeMaxDynamicSharedMemorySize, LDS_BYTES) != hipSuccess) { fprintf(stderr, "kernel_launch: hipFuncSetAttribute failed\n"); grid = -1; return; }
        if (hipOccupancyMaxActiveBlocksPerMultiprocessor(&per_cu, (const void*)fwd_kernel, NWAVES * 64, LDS_BYTES) != hipSuccess || per_cu < 1) { fprintf(stderr, "kernel_launch: occupancy query says %d blocks per CU\n", per_cu); (void)hipGetLastError(); grid = -1; return; }
        grid = cus;
    }
    if (grid < 0) return;
    (void)hipMemsetAsync((char*)d_ws + WS_CTL, 0, CTL_ZERO_BYTES, stream);
    Args a{};
    for (int i = 0; i < 19; ++i) a.in[i] = (const float*)d_in[i];
    a.out = (float*)d_out; a.ws = (unsigned char*)d_ws;
#if N_LAUNCH_SPLIT
    for (int ph = 0; ph < NPHASE; ++ph) { a.ph_lo = ph; a.ph_hi = ph + 1; a.use_bar = 0; hipLaunchKernelGGL(fwd_kernel, dim3(grid), dim3(NWAVES * 64), LDS_BYTES, stream, a); }
#else
    a.ph_lo = 0; a.ph_hi = NPHASE; a.use_bar = 1;
    void* kargs[] = {&a};
    hipError_t e = hipLaunchCooperativeKernel((const void*)fwd_kernel, dim3(grid), dim3(NWAVES * 64), kargs, LDS_BYTES, stream);
    if (e != hipSuccess) fprintf(stderr, "kernel_launch: cooperative launch failed: %s (grid %d)\n", hipGetErrorString(e), grid);
#endif
}
```
